# Optimizing an MI355X kernel written in HIP

```python
import jax, jax.numpy as jnp
from jax import lax
import numpy as np

D_MODEL = 1024
BATCH = 8
SEQ = 8192
DEPTH = 1

MIX_WIDTH = D_MODEL
POOL_WIDTH = MIX_WIDTH // 2
POOL_WINDOWS = (2, 4, 8, 16)
N_POOL_GROUPS = len(POOL_WINDOWS)
POOL_GROUP = POOL_WIDTH // N_POOL_GROUPS
HGRN_WIDTH = MIX_WIDTH - POOL_WIDTH
HGRN_HEAD_DIM = 128
HGRN_HEADS = HGRN_WIDTH // HGRN_HEAD_DIM
CHUNK = 64
D_FF = 2816
EPS = 1e-6
IN_COLS = POOL_WIDTH + 5 * HGRN_WIDTH

kernel_name = "hybrid_pool_hgrn2_macaron_encoder"


def rmsnorm(x, w):
    xf = x.astype(jnp.float32)
    y = xf * lax.rsqrt(jnp.mean(xf * xf, axis=-1, keepdims=True) + EPS)
    return (y * w.astype(jnp.float32)).astype(x.dtype)


def swiglu(x, w_gate, w_up, w_down):
    return (jax.nn.silu(x @ w_gate) * (x @ w_up)) @ w_down


def centred_mean_minus_self(z, window):
    S = z.shape[1]
    zf = z.astype(jnp.float32)
    csum = jnp.concatenate([jnp.zeros_like(zf[:, :1]), jnp.cumsum(zf, axis=1)], axis=1)
    t = jnp.arange(S)
    lo = jnp.clip(t - window // 2, 0, S)
    hi = jnp.clip(t + window - window // 2, 0, S)
    total = jnp.take(csum, hi, axis=1) - jnp.take(csum, lo, axis=1)
    count = (hi - lo).astype(jnp.float32)[None, :, None]
    return (total / count - zf).astype(z.dtype)


def pool_mixer(z, pool_w, pool_scale):
    B, S, _ = z.shape
    zg = z.reshape(B, S, N_POOL_GROUPS, POOL_GROUP)
    pooled = jnp.stack([centred_mean_minus_self(zg[:, :, g], w) for g, w in enumerate(POOL_WINDOWS)], axis=2)
    y = jnp.einsum('bsgc,gcd->bsgd', pooled, pool_w)
    return y.reshape(B, S, POOL_WIDTH) * pool_scale


def gated_linear_recurrence(q, k, v, log_f):
    B, N, S, DK = q.shape
    DV = v.shape[-1]
    nc = S // CHUNK

    def to_chunks(a):
        return a.reshape(B, N, nc, CHUNK, a.shape[-1]).transpose(2, 0, 1, 3, 4)

    qc, kc, vc, gc = to_chunks(q), to_chunks(k), to_chunks(v), to_chunks(log_f)
    lower_tri = jnp.tril(jnp.ones((CHUNK, CHUNK), dtype=bool))

    def step(state, inp):
        q_, k_, v_, g_ = inp
        b = jnp.cumsum(g_, axis=2)
        o_inter = jnp.einsum('bnck,bnkv->bncv', q_ * jnp.exp(b), state)
        diff = b[:, :, :, None, :] - b[:, :, None, :, :]
        decay = jnp.exp(jnp.where(lower_tri[:, :, None], diff, -jnp.inf))
        scores = jnp.einsum('bnik,bnijk,bnjk->bnij', q_, decay, k_)
        o = o_inter + jnp.einsum('bnij,bnjv->bniv', scores, v_)
        b_last = b[:, :, -1:, :]
        k_dec = k_ * jnp.exp(b_last - b)
        state = state * jnp.exp(b_last[:, :, 0, :, None]) + jnp.einsum('bnck,bncv->bnkv', k_dec, v_)
        return state, o

    s0 = jnp.zeros((B, N, DK, DV), jnp.float32)
    _, o = lax.scan(step, s0, (qc, kc, vc, gc))
    return o.transpose(1, 2, 0, 3, 4).reshape(B, N, S, DV)


def hgrn2_bidirectional(q_raw, i_raw, f_fwd_raw, f_bwd_raw, g_raw, hgrn_lb, gnorm_w, layer_idx):
    B, S, _ = q_raw.shape
    N = HGRN_HEADS
    lb = jnp.cumsum(jax.nn.softmax(hgrn_lb.astype(jnp.float32), axis=1), axis=1)[:, layer_idx]

    def heads(a):
        return a.reshape(B, S, N, HGRN_HEAD_DIM).transpose(0, 2, 1, 3)

    def gate(f_raw, lb_dir):
        f = lb_dir + (1.0 - lb_dir) * jax.nn.sigmoid(f_raw.astype(jnp.float32))
        return heads(jnp.log(f)), heads(1.0 - f)

    q = heads(jax.nn.silu(q_raw.astype(jnp.float32)))
    v = heads(i_raw.astype(jnp.float32))
    logf_fwd, k_fwd = gate(f_fwd_raw, lb[0])
    logf_bwd, k_bwd = gate(f_bwd_raw, lb[1])

    def flip(a):
        return jnp.flip(a, axis=2)

    qq = jnp.concatenate([q, flip(q)], axis=1)
    kk = jnp.concatenate([k_fwd, flip(k_bwd)], axis=1)
    vv = jnp.concatenate([v, flip(v)], axis=1)
    gg = jnp.concatenate([logf_fwd, flip(logf_bwd)], axis=1)
    o = gated_linear_recurrence(qq, kk, vv, gg)
    o = o[:, :N] + flip(o[:, N:])
    o = o.transpose(0, 2, 1, 3)
    o = o * lax.rsqrt(jnp.mean(o * o, axis=-1, keepdims=True) + EPS) * gnorm_w.astype(jnp.float32)
    o = o.reshape(B, S, HGRN_WIDTH) * jax.nn.silu(g_raw.astype(jnp.float32))
    return o.astype(q_raw.dtype)


def setup_inputs(seed: int = 0) -> dict:
    key = jax.random.key(seed)
    ks = jax.random.split(key, 20)
    f32 = jnp.float32

    def nrm(k, shape, fan_in):
        return jax.random.normal(k, shape, f32) * (fan_in ** -0.5)

    def gain(k, shape):
        return 1.0 + 0.02 * jax.random.normal(k, shape, f32)

    return {
        "x": jax.random.normal(ks[0], (BATCH, SEQ, D_MODEL), f32),
        "norm_ffn1": gain(ks[1], (DEPTH, D_MODEL)),
        "w_ffn1_gate": nrm(ks[2], (DEPTH, D_MODEL, D_FF), D_MODEL),
        "w_ffn1_up": nrm(ks[3], (DEPTH, D_MODEL, D_FF), D_MODEL),
        "w_ffn1_down": nrm(ks[4], (DEPTH, D_FF, D_MODEL), D_FF),
        "norm_mix": gain(ks[5], (DEPTH, D_MODEL)),
        "w_in": nrm(ks[6], (DEPTH, D_MODEL, IN_COLS), D_MODEL),
        "pool_w": nrm(ks[7], (DEPTH, N_POOL_GROUPS, POOL_GROUP, POOL_GROUP), POOL_GROUP),
        "pool_scale": gain(ks[8], (DEPTH, POOL_WIDTH)),
        "hgrn_lb": 0.1 * jax.random.normal(ks[9], (2, DEPTH + 1, HGRN_WIDTH), f32),
        "hgrn_gnorm": gain(ks[10], (DEPTH, HGRN_HEAD_DIM)),
        "w_out": nrm(ks[11], (DEPTH, MIX_WIDTH, D_MODEL), MIX_WIDTH),
        "norm_ffn2": gain(ks[12], (DEPTH, D_MODEL)),
        "w_ffn2_gate": nrm(ks[13], (DEPTH, D_MODEL, D_FF), D_MODEL),
        "w_ffn2_up": nrm(ks[14], (DEPTH, D_MODEL, D_FF), D_MODEL),
        "w_ffn2_down": nrm(ks[15], (DEPTH, D_FF, D_MODEL), D_FF),
        "norm_final": gain(ks[16], (D_MODEL,)),
    }


def reference(x, norm_ffn1, w_ffn1_gate, w_ffn1_up, w_ffn1_down, norm_mix, w_in, pool_w, pool_scale,
              hgrn_lb, hgrn_gnorm, w_out, norm_ffn2, w_ffn2_gate, w_ffn2_up, w_ffn2_down, norm_final):
    split_at = [POOL_WIDTH + j * HGRN_WIDTH for j in range(5)]
    h = x
    for l in range(DEPTH):
        h = h + 0.5 * swiglu(rmsnorm(h, norm_ffn1[l]), w_ffn1_gate[l], w_ffn1_up[l], w_ffn1_down[l])
        u = rmsnorm(h, norm_mix[l])
        proj = u @ w_in[l]
        z_pool, q_raw, i_raw, f_fwd_raw, f_bwd_raw, g_raw = jnp.split(proj, split_at, axis=-1)
        y_pool = pool_mixer(z_pool, pool_w[l], pool_scale[l])
        y_hgrn = hgrn2_bidirectional(q_raw, i_raw, f_fwd_raw, f_bwd_raw, g_raw,
                                     hgrn_lb, hgrn_gnorm[l], l)
        h = h + jnp.concatenate([y_pool, y_hgrn], axis=-1) @ w_out[l]
        h = h + 0.5 * swiglu(rmsnorm(h, norm_ffn2[l]), w_ffn2_gate[l], w_ffn2_up[l], w_ffn2_down[l])
    return rmsnorm(h, norm_final)
```

```cpp
#include <hip/hip_runtime.h>
#include <hip/hip_cooperative_groups.h>
#include <cstdio>
#include <cstdint>
namespace cg = cooperative_groups;
namespace pg8 {
#define PG8_LAS __attribute__((address_space(3)))
typedef unsigned short bf16_t;
typedef short bf16x8 __attribute__((ext_vector_type(8)));
typedef float f32x4 __attribute__((ext_vector_type(4)));
typedef unsigned u32x4 __attribute__((ext_vector_type(4)));
constexpr int BM = 256, BK = 64, HALF = 128, HTB = HALF * BK * 2  , STAGE_BYTES = 8 * HTB, NXCD = 8, WGM = 8;

__host__ __device__ __forceinline__ int lds_byte(int r, int c) { const int st = (r >> 4) * 2 + (c >> 5), rr = r & 15, cc = c & 31, ob = rr * 64 + cc * 2; return st * 1024 + (ob ^ (((ob >> 9) & 1) << 5)); }
__host__ __device__ __forceinline__ void stage_rc(int b, int& R, int& C) { const int st = b / 1024, sb = b % 1024, swz = sb ^ (((sb >> 9) & 1) << 5); R = (st >> 1) * 16 + swz / 64; C = (st & 1) * 32 + (swz % 64) / 2; }
__host__ __device__ __forceinline__ int perm32(int rho) { const int n = rho >> 4, i = rho & 15; return 8 * (i >> 2) + 4 * n + (i & 3); }

struct Unit { int pm, pn; };
struct Gemm { const bf16_t* A; const bf16_t* Bt; int M, N, K; };

struct StaticOrder {
    int nM, nN, nwg, G, c, rev;
    __host__ __device__ void init(int M, int N, int G_, int c_, int rev_ = 0) { nM = M / BM; nN = N / BM; nwg = nM * nN; G = G_; c = c_; rev = rev_; }
    __host__ __device__ bool next(int i, Unit& u) const {
        const long L = (long)i * G + c; if (L >= nwg) return false;
        int wgid = (int)L; { const int q = nwg / NXCD, r = nwg % NXCD, xcd = wgid % NXCD; int off = wgid / NXCD; if (rev && r == 0) off = q - 1 - off; wgid = (xcd < r ? xcd * (q + 1) : r * (q + 1) + (xcd - r) * q) + off; }
        const int nig = WGM * nN, gid = wgid / nig, fm = gid * WGM, gsz = (nM - fm) < WGM ? (nM - fm) : WGM;
        u.pm = fm + ((wgid % nig) % gsz); u.pn = (wgid % nig) / gsz; return true;
    }
    __device__ __forceinline__ void a_ready(const Unit&) const {}
    __device__ __forceinline__ void done(const Unit&) const {}
};
typedef float f32x2 __attribute__((ext_vector_type(2)));
typedef __bf16 bf16x2_t __attribute__((ext_vector_type(2)));
__device__ __forceinline__ unsigned cvt_pk_bf16(float lo, float hi) { f32x2 v = {lo, hi}; bf16x2_t b = __builtin_convertvector(v, bf16x2_t); return __builtin_bit_cast(unsigned, b); }

constexpr float RMS_EPS = 1e-6f;
__device__ __forceinline__ float fast_sigmoid(float v) { return __builtin_amdgcn_rcpf(1.0f + __expf(-v)); }
__device__ __forceinline__ float silu_f(float v) { return v * fast_sigmoid(v); }

struct EpiSwiglu {
    static constexpr bool PERM = true, AFTER_DRAIN = false;
    bf16_t* O; int ldc; const float* ssq;
    __device__ __forceinline__ void operator()(const f32x4 (&acc)[2][2][4][2], const Unit& u, int wr, int wc, int fr, int fq) const {
        const int row0 = u.pm * BM + wr * 64 + fr, col0 = u.pn * HALF + wc * 32 + 8 * fq;
#pragma unroll
        for (int ai = 0; ai < 2; ++ai)
#pragma unroll
            for (int m = 0; m < 4; ++m) { const int row = row0 + ai * HALF + m * 16;
                const float r = __builtin_amdgcn_rsqf(ssq[row] * (1.0f / 1024.0f) + RMS_EPS);
                float h[8];
#pragma unroll
                for (int n = 0; n < 2; ++n)
#pragma unroll
                    for (int e = 0; e < 4; ++e) { const float g = acc[ai][0][m][n][e] * r, up = acc[ai][1][m][n][e] * r; h[4 * n + e] = silu_f(g) * up; }
                u32x4 w; w.x = cvt_pk_bf16(h[0], h[1]); w.y = cvt_pk_bf16(h[2], h[3]); w.z = cvt_pk_bf16(h[4], h[5]); w.w = cvt_pk_bf16(h[6], h[7]);
                *(u32x4*)(O + (size_t)row * ldc + col0) = w; }
    }
};
struct EpiResid {
    static constexpr bool PERM = true, AFTER_DRAIN = false;
    bf16_t* hb; float* ssq_out; float scale; int ldc;
    __device__ __forceinline__ void operator()(const f32x4 (&acc)[2][2][4][2], const Unit& u, int wr, int wc, int fr, int fq) const {
        const int row0 = u.pm * BM + wr * 64 + fr, col0 = u.pn * BM + wc * 32 + 8 * fq;
#pragma unroll
        for (int ai = 0; ai < 2; ++ai)
#pragma unroll
            for (int m = 0; m < 4; ++m) { const int row = row0 + ai * HALF + m * 16; const size_t off = (size_t)row * ldc + col0; float s = 0.f;
                u32x4 bw[2];
#pragma unroll
                for (int bj = 0; bj < 2; ++bj) bw[bj] = *(const u32x4*)(hb + off + bj * HALF);
#pragma unroll
                for (int bj = 0; bj < 2; ++bj) {
                    const f32x4 b0 = (f32x4){__uint_as_float(bw[bj].x << 16), __uint_as_float(bw[bj].x & 0xffff0000u), __uint_as_float(bw[bj].y << 16), __uint_as_float(bw[bj].y & 0xffff0000u)};
                    const f32x4 b1 = (f32x4){__uint_as_float(bw[bj].z << 16), __uint_as_float(bw[bj].z & 0xffff0000u), __uint_as_float(bw[bj].w << 16), __uint_as_float(bw[bj].w & 0xffff0000u)};
                    const f32x4 v0 = b0 + acc[ai][bj][m][0] * scale, v1 = b1 + acc[ai][bj][m][1] * scale;
                    u32x4 w; w.x = cvt_pk_bf16(v0[0], v0[1]); w.y = cvt_pk_bf16(v0[2], v0[3]); w.z = cvt_pk_bf16(v1[0], v1[1]); w.w = cvt_pk_bf16(v1[2], v1[3]);
                    *(u32x4*)(hb + off + bj * HALF) = w;
                    s += (v0[0] * v0[0] + v0[1] * v0[1]) + (v0[2] * v0[2] + v0[3] * v0[3]) + (v1[0] * v1[0] + v1[1] * v1[1]) + (v1[2] * v1[2] + v1[3] * v1[3]); }
                s += __shfl_xor(s, 16); s += __shfl_xor(s, 32);
                if (fq == 0) unsafeAtomicAdd(ssq_out + row, s); }
    }
};
struct EpiProj {
    static constexpr bool PERM = true, AFTER_DRAIN = false;
    bf16_t* O; int ldc; const float* ssq; const float* omlb;
    __device__ __forceinline__ void operator()(const f32x4 (&acc)[2][2][4][2], const Unit& u, int wr, int wc, int fr, int fq) const {
        const int row0 = u.pm * BM + wr * 64 + fr, col0 = u.pn * BM + wc * 32 + 8 * fq; const int type = u.pn >> 1;
        float ol[2][8];
#pragma unroll
        for (int bj = 0; bj < 2; ++bj)
#pragma unroll
            for (int e = 0; e < 8; ++e) ol[bj][e] = (type == 3 || type == 4) ? omlb[col0 + bj * HALF + e - 1536] : 0.f;
#pragma unroll
        for (int ai = 0; ai < 2; ++ai)
#pragma unroll
            for (int m = 0; m < 4; ++m) { const int row = row0 + ai * HALF + m * 16;
                const float r = __builtin_amdgcn_rsqf(ssq[row] * (1.0f / 1024.0f) + RMS_EPS);
#pragma unroll
                for (int bj = 0; bj < 2; ++bj) { float h[8];
#pragma unroll
                    for (int n = 0; n < 2; ++n)
#pragma unroll
                        for (int e = 0; e < 4; ++e) { const float v = acc[ai][bj][m][n][e] * r; float o = v;
                            if (type == 1 || type == 5) o = silu_f(v);
                            if (type == 3 || type == 4) o = ol[bj][4 * n + e] * __builtin_amdgcn_rcpf(1.0f + __expf(v));
                            h[4 * n + e] = o; }
                    u32x4 w; w.x = cvt_pk_bf16(h[0], h[1]); w.y = cvt_pk_bf16(h[2], h[3]); w.z = cvt_pk_bf16(h[4], h[5]); w.w = cvt_pk_bf16(h[6], h[7]);
                    u32x4* dst = (u32x4*)(O + (size_t)row * ldc + col0 + bj * HALF);
                    if (type == 1 || type == 5) __builtin_nontemporal_store(w, dst); else *dst = w; } }
    }
};
struct EpiPlain {
    static constexpr bool PERM = true, AFTER_DRAIN = false;
    bf16_t* O; int ldc;
    __device__ __forceinline__ void operator()(const f32x4 (&acc)[2][2][4][2], const Unit& u, int wr, int wc, int fr, int fq) const {
        const int row0 = u.pm * BM + wr * 64 + fr, col0 = u.pn * BM + wc * 32 + 8 * fq;
#pragma unroll
        for (int ai = 0; ai < 2; ++ai)
#pragma unroll
            for (int m = 0; m < 4; ++m) { const int row = row0 + ai * HALF + m * 16;
#pragma unroll
                for (int bj = 0; bj < 2; ++bj) { const f32x4 v0 = acc[ai][bj][m][0], v1 = acc[ai][bj][m][1];
                    u32x4 w; w.x = cvt_pk_bf16(v0[0], v0[1]); w.y = cvt_pk_bf16(v0[2], v0[3]); w.z = cvt_pk_bf16(v1[0], v1[1]); w.w = cvt_pk_bf16(v1[2], v1[3]);
                    *(u32x4*)(O + (size_t)row * ldc + col0 + bj * HALF) = w; } }
    }
};

template <class Epi, class Sched, bool ALIGN_EPI = false, bool SP2 = false>
__device__ __forceinline__ void gemm_phase(PG8_LAS unsigned char* lds, const Gemm g, const Sched& S, const Epi& E) {
    const int tid = threadIdx.x, wid = __builtin_amdgcn_readfirstlane(tid >> 6), lane = tid & 63, wr = wid >> 2, wc = wid & 3, fr = lane & 15, fq = lane >> 4;
    const int K = g.K, nt = K / BK;
    unsigned voffA[2], voffB[2];
#pragma unroll
    for (int i = 0; i < 2; ++i) { int R, C; stage_rc(tid * 16 + i * 8192, R, C); const int Rb = Epi::PERM ? ((R & ~31) + perm32(R & 31)) : R;
        voffA[i] = (unsigned)(R * K + C) * 2u; voffB[i] = (unsigned)(Rb * K + C) * 2u; }
    const size_t kstep = (size_t)(BK * 2);
    const size_t hstep = (size_t)HALF * K * 2;
    const size_t tstep = 2 * hstep;
    const unsigned ldsw = (unsigned)wid * 1024u;
    const int aoff = lds_byte(wr * 64 + fr, fq * 8), boff = lds_byte(wc * 32 + fr, fq * 8);
#define PG8_SA(b, h) (((b) * 2 + (h)) * HTB)
#define PG8_SB(b, h) ((4 + (b) * 2 + (h)) * HTB)
#define PG8_STAGE(bufoff, gbase, voff) do { _Pragma("unroll") for (int _i = 0; _i < 2; ++_i) \
        __builtin_amdgcn_global_load_lds((const unsigned*)((const char*)(gbase) + (voff)[_i]), (PG8_LAS unsigned*)(lds + (bufoff) + ldsw + _i * 8192), 16, 0, 0); } while (0)
#define PG8_LDA(dst, b, h) do { _Pragma("unroll") for (int m = 0; m < 4; ++m) _Pragma("unroll") for (int k = 0; k < 2; ++k) dst[m][k] = *(const PG8_LAS bf16x8*)(lds + PG8_SA(b, h) + aoff + m * 2048 + k * 1024); } while (0)
#define PG8_LDB(dst, b, h) do { _Pragma("unroll") for (int n = 0; n < 2; ++n) _Pragma("unroll") for (int k = 0; k < 2; ++k) dst[n][k] = *(const PG8_LAS bf16x8*)(lds + PG8_SB(b, h) + boff + n * 2048 + k * 1024); } while (0)
#define PG8_MMA(ai, bj, At, Bt) do { __builtin_amdgcn_s_setprio(1); _Pragma("unroll") for (int m = 0; m < 4; ++m) _Pragma("unroll") for (int n = 0; n < 2; ++n) _Pragma("unroll") for (int k = 0; k < 2; ++k) \
        acc[ai][bj][m][n] = __builtin_amdgcn_mfma_f32_16x16x32_bf16(Bt[n][k], At[m][k], acc[ai][bj][m][n], 0, 0, 0); __builtin_amdgcn_s_setprio(0); } while (0)
#define PG8_WAIT_V(n) asm volatile("s_waitcnt vmcnt(" #n ")" ::: "memory")
#define PG8_WAIT_L(n) asm volatile("s_waitcnt lgkmcnt(" #n ")" ::: "memory")
#define PG8_BAR __builtin_amdgcn_s_barrier()
#define PG8_SCHED __builtin_amdgcn_sched_barrier(0)
    Unit cur, nxt; int ui = 0;
    if (!S.next(0, cur)) return;
    f32x4 acc[2][2][4][2];
#pragma unroll
    for (int a = 0; a < 2; ++a)
#pragma unroll
        for (int b = 0; b < 2; ++b)
#pragma unroll
            for (int m = 0; m < 4; ++m)
#pragma unroll
                for (int n = 0; n < 2; ++n) acc[a][b][m][n] = (f32x4){0.f, 0.f, 0.f, 0.f};
    bf16x8 At[4][2], B0[2][2], B1[2][2];
    const char* cA = (const char*)g.A + (size_t)cur.pm * tstep; const char* cB = (const char*)g.Bt + (size_t)cur.pn * tstep;
    S.a_ready(cur);
    if constexpr (SP2) {
        PG8_STAGE(PG8_SB(0, 0), cB, voffB); PG8_STAGE(PG8_SB(0, 1), cB + hstep, voffB); PG8_STAGE(PG8_SA(0, 0), cA, voffA); PG8_STAGE(PG8_SA(0, 1), cA + hstep, voffA);
        if (wr == 1) PG8_BAR;
        PG8_WAIT_V(2); PG8_BAR;
        PG8_STAGE(PG8_SB(1, 0), cB + kstep, voffB); PG8_STAGE(PG8_SA(1, 0), cA + kstep, voffA); PG8_STAGE(PG8_SB(1, 1), cB + hstep + kstep, voffB);
        PG8_WAIT_V(6); PG8_BAR;
    } else {
        PG8_STAGE(PG8_SB(0, 0), cB, voffB); PG8_STAGE(PG8_SA(0, 0), cA, voffA); PG8_STAGE(PG8_SB(0, 1), cB + hstep, voffB); PG8_STAGE(PG8_SA(0, 1), cA + hstep, voffA);
        if (wr == 1) PG8_BAR;
        PG8_WAIT_V(4); PG8_BAR;
        PG8_STAGE(PG8_SB(1, 0), cB + kstep, voffB); PG8_STAGE(PG8_SA(1, 0), cA + kstep, voffA); PG8_STAGE(PG8_SB(1, 1), cB + hstep + kstep, voffB);
        PG8_WAIT_V(6); PG8_BAR;
    }
    for (;;) {
        const bool has_next = S.next(ui + 1, nxt);
        const char* nA = has_next ? (const char*)g.A + (size_t)nxt.pm * tstep : cA; const char* nB = has_next ? (const char*)g.Bt + (size_t)nxt.pn * tstep : cB;
        for (int t = 0; t < nt; t += 2) {
            const bool last = (t == nt - 2);
            const char* a1 = cA + (size_t)(t + 1) * kstep;
            const char* a2 = last ? nA : cA + (size_t)(t + 2) * kstep; const char* b2 = last ? nB : cB + (size_t)(t + 2) * kstep;
            const char* a3 = a2 + kstep; const char* b3 = b2 + kstep;
            if (last && has_next) S.a_ready(nxt);
            if constexpr (SP2) {
            PG8_LDB(B0, 0, 0); PG8_LDB(B1, 0, 1); PG8_SCHED; PG8_LDA(At, 0, 0); PG8_STAGE(PG8_SA(1, 1), a1 + hstep, voffA);
            PG8_WAIT_V(8); PG8_WAIT_L(0); PG8_BAR; PG8_MMA(0, 0, At, B0); PG8_MMA(0, 1, At, B1); PG8_BAR; PG8_SCHED;
            PG8_LDA(At, 0, 1); PG8_STAGE(PG8_SB(0, 0), b2, voffB); PG8_STAGE(PG8_SB(0, 1), b2 + hstep, voffB); PG8_STAGE(PG8_SA(0, 0), a2, voffA);
            PG8_WAIT_V(8); PG8_WAIT_L(0); PG8_BAR; PG8_MMA(1, 0, At, B0); PG8_MMA(1, 1, At, B1); PG8_BAR; PG8_SCHED;
            PG8_LDB(B0, 1, 0); PG8_LDB(B1, 1, 1); PG8_SCHED; PG8_LDA(At, 1, 0); PG8_STAGE(PG8_SA(0, 1), a2 + hstep, voffA);
            PG8_WAIT_V(8); PG8_WAIT_L(0); PG8_BAR; PG8_MMA(0, 0, At, B0); PG8_MMA(0, 1, At, B1); PG8_BAR; PG8_SCHED;
            PG8_LDA(At, 1, 1); PG8_STAGE(PG8_SB(1, 0), b3, voffB); PG8_STAGE(PG8_SB(1, 1), b3 + hstep, voffB); PG8_STAGE(PG8_SA(1, 0), a3, voffA);
            PG8_WAIT_V(8); PG8_WAIT_L(0); PG8_BAR; PG8_MMA(1, 0, At, B0); PG8_MMA(1, 1, At, B1); PG8_BAR; PG8_SCHED;
            } else {
            PG8_LDB(B0, 0, 0); PG8_SCHED; PG8_LDA(At, 0, 0); PG8_STAGE(PG8_SA(1, 1), a1 + hstep, voffA);
            PG8_WAIT_L(8); PG8_BAR; PG8_WAIT_L(0); PG8_MMA(0, 0, At, B0); PG8_BAR; PG8_SCHED;
            PG8_LDB(B1, 0, 1); PG8_STAGE(PG8_SB(0, 0), b2, voffB);
            PG8_BAR; PG8_WAIT_L(0); PG8_MMA(0, 1, At, B1); PG8_BAR;
            PG8_LDA(At, 0, 1); PG8_STAGE(PG8_SA(0, 0), a2, voffA);
            PG8_BAR; PG8_WAIT_L(0); PG8_MMA(1, 0, At, B0); PG8_BAR; PG8_SCHED;
            PG8_STAGE(PG8_SB(0, 1), b2 + hstep, voffB);
            PG8_WAIT_V(6); PG8_BAR; PG8_MMA(1, 1, At, B1); PG8_BAR;
            PG8_LDB(B0, 1, 0); PG8_SCHED; PG8_LDA(At, 1, 0); PG8_STAGE(PG8_SA(0, 1), a2 + hstep, voffA);
            PG8_WAIT_L(8); PG8_BAR; PG8_WAIT_L(0); PG8_MMA(0, 0, At, B0); PG8_BAR; PG8_SCHED;
            PG8_LDB(B1, 1, 1); PG8_STAGE(PG8_SB(1, 0), b3, voffB);
            PG8_BAR; PG8_WAIT_L(0); PG8_MMA(0, 1, At, B1); PG8_BAR;
            PG8_LDA(At, 1, 1); PG8_STAGE(PG8_SA(1, 0), a3, voffA);
            PG8_BAR; PG8_WAIT_L(0); PG8_MMA(1, 0, At, B0); PG8_BAR; PG8_SCHED;
            PG8_STAGE(PG8_SB(1, 1), b3 + hstep, voffB);
            PG8_WAIT_V(6); PG8_BAR; PG8_MMA(1, 1, At, B1); PG8_BAR;
            }
        }
        if constexpr (ALIGN_EPI) { if (wr == 0) PG8_BAR; }
        if constexpr (!Epi::AFTER_DRAIN) { E(acc, cur, wr, wc, fr, fq); S.done(cur); }
        if (!has_next) break;
#pragma unroll
        for (int a = 0; a < 2; ++a)
#pragma unroll
            for (int b = 0; b < 2; ++b)
#pragma unroll
                for (int m = 0; m < 4; ++m)
#pragma unroll
                    for (int n = 0; n < 2; ++n) acc[a][b][m][n] = (f32x4){0.f, 0.f, 0.f, 0.f};
        cur = nxt; cA = nA; cB = nB; ++ui;
        if constexpr (ALIGN_EPI) { if (wr == 1) PG8_BAR; }
    }
    PG8_WAIT_V(0);
    if constexpr (!ALIGN_EPI) { if (wr == 0) PG8_BAR; }
    PG8_BAR;
    if constexpr (Epi::AFTER_DRAIN) { E.fused(acc, cur, wr, wc, fr, fq, lds, wid, lane); S.done(cur); }
#undef PG8_SA
#undef PG8_SB
#undef PG8_STAGE
#undef PG8_LDA
#undef PG8_LDB
#undef PG8_MMA
#undef PG8_WAIT_V
#undef PG8_WAIT_L
#undef PG8_BAR
#undef PG8_SCHED
}
}

constexpr int NWAVES = 8;
constexpr int BATCH = 8, SEQ = 8192, D = 1024, FF = 2816, INC = 3072, PW = 512, HW = 512, HD = 128;
constexpr int M = BATCH * SEQ;
constexpr float EPS = 1e-6f;
constexpr size_t MiB = 1u << 20;
constexpr size_t WS_SSQ = 0;
constexpr size_t WS_BAR = 1 * MiB + 512 * 1024;
constexpr size_t WS_OMLB = 1 * MiB;
constexpr size_t WS_WGU1 = 2 * MiB;
constexpr size_t WS_WD1 = 13 * MiB;
constexpr size_t WS_WIN = 19 * MiB;
constexpr size_t WS_WOUT = 25 * MiB;
constexpr size_t WS_WGU2 = 27 * MiB;
constexpr size_t WS_WD2 = 38 * MiB;
constexpr size_t WS_WPOOL = 44 * MiB;
constexpr size_t WS_ACTB = 48 * MiB;
constexpr size_t WS_YMIX = 176 * MiB;
constexpr size_t WS_PROJ = 304 * MiB;
constexpr size_t WS_LT = 688 * MiB;
constexpr size_t WS_POOLED = 944 * MiB;
constexpr size_t WS_END = 1008 * MiB;
constexpr int LDS_BYTES = 147456;

#define LAS __attribute__((address_space(3)))
typedef unsigned short bf16;
typedef unsigned v4u __attribute__((ext_vector_type(4)));
typedef unsigned v2u __attribute__((ext_vector_type(2)));
typedef float f32x4 __attribute__((ext_vector_type(4)));
typedef float f32x2 __attribute__((ext_vector_type(2)));
#define LDS_WAIT() asm volatile("s_waitcnt lgkmcnt(0)" ::: "memory")
__device__ __forceinline__ unsigned pk2(float lo, float hi) { return pg8::cvt_pk_bf16(lo, hi); }
__device__ __forceinline__ float bflo(unsigned w) { return __uint_as_float(w << 16); }
__device__ __forceinline__ float bfhi(unsigned w) { return __uint_as_float(w & 0xffff0000u); }
__device__ __forceinline__ float wave_sum(float v) {
#pragma unroll
    for (int o = 1; o < 64; o <<= 1) v += __shfl_xor(v, o);
    return v;
}

__device__ __forceinline__ void transpose_item(const float* W, int N, bf16* WT, int ldk, int koff, int mode, int rowoff, const float* ks, const float* ns, LAS float* scr, int item, int lane) {
    const int nblk = N / 32, kb = item / nblk, nb = item % nblk, k0 = 64 * kb, n0 = 32 * nb;
#pragma unroll
    for (int i = 0; i < 32; ++i) { const int kk = 2 * i + (lane >> 5); float w = __builtin_nontemporal_load(W + (size_t)(k0 + kk) * N + n0 + (lane & 31)); if (ks) w *= ks[k0 + kk]; scr[kk * 33 + (lane & 31)] = w; }
    LDS_WAIT(); asm volatile("" ::: "memory");
    const int c = lane & 7;
#pragma unroll
    for (int j = 0; j < 4; ++j) { const int n = (lane >> 3) + 8 * j; const LAS float* s = scr + (8 * c) * 33 + n; const float sc = ns ? ns[n0 + n] : 1.0f;
        v4u o; o.x = pk2(s[0 * 33] * sc, s[1 * 33] * sc); o.y = pk2(s[2 * 33] * sc, s[3 * 33] * sc); o.z = pk2(s[4 * 33] * sc, s[5 * 33] * sc); o.w = pk2(s[6 * 33] * sc, s[7 * 33] * sc);
        const int ng = n0 + n; const int drow = (mode == 1) ? (256 * (ng >> 7) + rowoff + (ng & 127)) : (rowoff + ng);
        *(v4u*)(WT + (size_t)drow * ldk + koff + k0 + 8 * c) = o; }
    LDS_WAIT(); asm volatile("" ::: "memory");
}

#define XB_TMO      128
#define XB_XCNT(j)  (256  + 64 * (j))
#define XB_XSUB(j)  (1280 + 64 * (j))
#define XB_XGEN(j)  (2304 + 64 * (j))
#define XB_TOP      3328
#define XB_TOPGEN   3392
#define XCD_BAR_WORDS 3456
#define XB_SPIN_CAP (1u << 18)

__device__ __forceinline__ unsigned xb_ld(unsigned* p)              { return __hip_atomic_load(p, __ATOMIC_RELAXED, __HIP_MEMORY_SCOPE_AGENT); }
__device__ __forceinline__ unsigned xb_add(unsigned* p, unsigned v) { return __hip_atomic_fetch_add(p, v, __ATOMIC_RELAXED, __HIP_MEMORY_SCOPE_AGENT); }
__device__ __forceinline__ unsigned xb_xcc_id() { return (unsigned)__builtin_amdgcn_s_getreg((3 << 11) | 20) & 0xFu; }
#define XB_SPIN(cond, bar) do { unsigned _sp = 0; while (cond) { __builtin_amdgcn_s_sleep(1); \
    if ((++_sp & 255u) == 0u) { if (xb_ld(&(bar)[XB_TMO])) break; if (_sp > XB_SPIN_CAP) { atomicAdd(&(bar)[XB_TMO], 1u); break; } } } } while (0)

struct XcdBarrier {
    unsigned* bar; unsigned x;
    volatile LAS unsigned* st;
};

__device__ __forceinline__ XcdBarrier xcd_barrier_post(unsigned* bar, volatile LAS unsigned* st) {
    XcdBarrier b; b.bar = bar; b.x = xb_xcc_id(); b.st = st;
    if (threadIdx.x == 0) (void)xb_add(&bar[XB_XCNT(b.x)], 1u);
    return b;
}
__device__ __forceinline__ void xcd_barrier_complete(unsigned* bar, unsigned x, unsigned& nloc, unsigned& nx) {
    const unsigned G = gridDim.x * gridDim.y * gridDim.z;
    unsigned sum, cnt, mine, sp = 0u;
    for (;;) {
        sum = 0u; cnt = 0u; mine = 0u;
#pragma unroll
        for (unsigned j = 0; j < 16; ++j) { const unsigned c = xb_ld(&bar[XB_XCNT(j)]); sum += c; cnt += (c > 0u) ? 1u : 0u; mine = (j == x) ? c : mine; }
        if (sum == G) break;
        __builtin_amdgcn_s_sleep(1);
        if ((++sp & 255u) == 0u) { if (xb_ld(&bar[XB_TMO])) break; if (sp > XB_SPIN_CAP) { atomicAdd(&bar[XB_TMO], 1u); break; } }
    }
    nloc = mine > 0u ? mine : 1u; nx = cnt > 0u ? cnt : 1u;
}

__device__ __forceinline__ void xcd_barrier(const XcdBarrier& b) {
    asm volatile("s_waitcnt vmcnt(0)" ::: "memory");
    __syncthreads();
    if (threadIdx.x == 0) {
        unsigned* bar = b.bar;
        __builtin_amdgcn_s_waitcnt(0);
        unsigned nloc = b.st[0], nx = b.st[1];
        if (nloc == 0u) { xcd_barrier_complete(bar, b.x, nloc, nx); b.st[0] = nloc; b.st[1] = nx; }
        const unsigned old = xb_add(&bar[XB_XSUB(b.x)], 1u);
        const unsigned gen = old / nloc;
        if (old + 1u == (gen + 1u) * nloc) {
            __builtin_amdgcn_fence(__ATOMIC_RELEASE, "agent");
            asm volatile("s_waitcnt vmcnt(0)" ::: "memory");
            const unsigned og = xb_add(&bar[XB_TOP], 1u);
            const unsigned tg = og / nx;
            if (og + 1u == (tg + 1u) * nx) xb_add(&bar[XB_TOPGEN], 1u);
            else XB_SPIN(xb_ld(&bar[XB_TOPGEN]) == tg, bar);
            __builtin_amdgcn_fence(__ATOMIC_ACQUIRE, "agent");
            xb_add(&bar[XB_XGEN(b.x)], 1u);
            asm volatile("s_waitcnt vmcnt(0)" ::: "memory");
        } else {
            XB_SPIN(xb_ld(&bar[XB_XGEN(b.x)]) == gen, bar);
            __builtin_amdgcn_fence(__ATOMIC_ACQUIRE, "agent");
            asm volatile("s_waitcnt vmcnt(0)" ::: "memory");
        }
    }
    __syncthreads();
}

struct Args { const float* in[17]; float* out; unsigned char* ws; };

__device__ __forceinline__ void p0_prologue(const Args& a, LAS unsigned char* lds, int gw, int NGW, int wave, int lane) {
    unsigned char* ws = a.ws;
    LAS float* scr = (LAS float*)(lds + wave * 16384);
    constexpr int I_GU = (D / 64) * (FF / 32), I_DN = (FF / 64) * (D / 32), I_IN = (D / 64) * (INC / 32), I_OUT = (HW / 64) * (D / 32);
    constexpr int NITEMS = 4 * I_GU + 2 * I_DN + I_IN + I_OUT;
    for (int it = gw; it < NITEMS; it += NGW) {
        int r = it;
        if (r < I_GU) { transpose_item(a.in[2], FF, (bf16*)(ws + WS_WGU1), D, 0, 1, 0, a.in[1], nullptr, scr, r, lane); continue; } r -= I_GU;
        if (r < I_GU) { transpose_item(a.in[3], FF, (bf16*)(ws + WS_WGU1), D, 0, 1, 128, a.in[1], nullptr, scr, r, lane); continue; } r -= I_GU;
        if (r < I_GU) { transpose_item(a.in[13], FF, (bf16*)(ws + WS_WGU2), D, 0, 1, 0, a.in[12], nullptr, scr, r, lane); continue; } r -= I_GU;
        if (r < I_GU) { transpose_item(a.in[14], FF, (bf16*)(ws + WS_WGU2), D, 0, 1, 128, a.in[12], nullptr, scr, r, lane); continue; } r -= I_GU;
        if (r < I_DN) { transpose_item(a.in[4], D, (bf16*)(ws + WS_WD1), FF, 0, 0, 0, nullptr, nullptr, scr, r, lane); continue; } r -= I_DN;
        if (r < I_DN) { transpose_item(a.in[15], D, (bf16*)(ws + WS_WD2), FF, 0, 0, 0, nullptr, nullptr, scr, r, lane); continue; } r -= I_DN;
        if (r < I_IN) { transpose_item(a.in[6], INC, (bf16*)(ws + WS_WIN), D, 0, 0, 0, a.in[5], nullptr, scr, r, lane); continue; } r -= I_IN;
        transpose_item(a.in[11], D, (bf16*)(ws + WS_WOUT), D, 0, 0, 0, nullptr, nullptr, scr, r + (PW / 64) * (D / 32), lane);
    }
    for (int wi = gw; wi < 2048; wi += NGW) {
        const int n = (wi & 15) * 64 + lane, kq = wi >> 4, g = kq >> 5, c0 = (kq & 31) * 4;
        const float* wo = a.in[11] + (size_t)(g * 128) * D + n; const float* pw = a.in[7] + (size_t)(g * 128 + c0) * 128; const float* ps = a.in[8] + g * 128;
        f32x4 acc4 = (f32x4){0.f, 0.f, 0.f, 0.f};
#pragma unroll 8
        for (int d = 0; d < 128; d += 4) {
            const f32x4 p4 = *(const f32x4*)(ps + d);
            const f32x4 w4 = (f32x4){wo[(size_t)d * D], wo[(size_t)(d + 1) * D], wo[(size_t)(d + 2) * D], wo[(size_t)(d + 3) * D]} * p4;
#pragma unroll
            for (int e = 0; e < 4; ++e) { const f32x4 q4 = *(const f32x4*)(pw + e * 128 + d); acc4[e] += (w4[0] * q4[0] + w4[1] * q4[1]) + (w4[2] * q4[2] + w4[3] * q4[3]); } }
        *(v2u*)((bf16*)(ws + WS_WOUT) + (size_t)n * D + kq * 4) = (v2u){pk2(acc4[0], acc4[1]), pk2(acc4[2], acc4[3])};
    }
    const float* x = a.in[0]; bf16* xb = (bf16*)(ws + WS_ACTB); float* ssq = (float*)(ws + WS_SSQ);
    for (int m = gw; m < M; m += NGW) {
        const f32x4* xr = (const f32x4*)(x + (size_t)m * D) + lane; f32x4 v[4]; float s = 0.f;
#pragma unroll
        for (int j = 0; j < 4; ++j) { v[j] = __builtin_nontemporal_load(xr + 64 * j); s += (v[j].x * v[j].x + v[j].y * v[j].y) + (v[j].z * v[j].z + v[j].w * v[j].w); }
        s = wave_sum(s);
        v2u* o8 = (v2u*)(xb + (size_t)m * D) + lane;
#pragma unroll
        for (int j = 0; j < 4; ++j) o8[64 * j] = (v2u){pk2(v[j].x, v[j].y), pk2(v[j].z, v[j].w)};
        if (lane == 0) { ssq[m] = s; ssq[M + m] = 0.f; ssq[2 * M + m] = 0.f; ssq[3 * M + m] = 0.f; }
    }
    if (gw < 16) { const int i = gw * 64 + lane; const int d = i >> 9, w = i & 511; const float a0 = a.in[9][d * 1024 + w], a1 = a.in[9][d * 1024 + 512 + w];
        ((float*)(ws + WS_OMLB))[i] = 1.0f / (1.0f + expf(a0 - a1)); }
}

__device__ __forceinline__ void pool_rows(const bf16* proj, bf16* pooled, int gw, int NGW, int lane) {
    const int g = lane >> 4, half = 1 << g;
    float mul[16];
#pragma unroll
    for (int d = 0; d < 16; ++d) mul[d] = (d - 8 >= -half && d - 8 < half) ? 1.0f : 0.0f;
    for (int blk = gw; blk < M / 8; blk += NGW) {
        const int m0 = blk * 8, t0 = m0 & (SEQ - 1);
        const bf16* base = proj + (size_t)(m0 - t0) * INC + lane * 8;
        v4u z[24];
#pragma unroll
        for (int j = 0; j < 24; ++j) { const int t = t0 - 8 + j; z[j] = (t >= 0 && t < SEQ) ? __builtin_nontemporal_load((const v4u*)(base + (size_t)t * INC)) : (v4u){0u, 0u, 0u, 0u}; }
#pragma unroll
        for (int r = 0; r < 8; ++r) {
            float s[8];
#pragma unroll
            for (int e = 0; e < 8; ++e) s[e] = 0.f;
#pragma unroll
            for (int d = 0; d < 16; ++d) { const v4u w = z[r + d]; const float ml = mul[d];
                s[0] += ml * bflo(w.x); s[1] += ml * bfhi(w.x); s[2] += ml * bflo(w.y); s[3] += ml * bfhi(w.y); s[4] += ml * bflo(w.z); s[5] += ml * bfhi(w.z); s[6] += ml * bflo(w.w); s[7] += ml * bfhi(w.w); }
            const int t = t0 + r; const int lo = (t - half) < 0 ? 0 : (t - half), hi = (t + half) > SEQ ? SEQ : (t + half);
            const float inv = 1.0f / (float)(hi - lo); const v4u zc = z[r + 8];
            v4u o; o.x = pk2(s[0] * inv - bflo(zc.x), s[1] * inv - bfhi(zc.x)); o.y = pk2(s[2] * inv - bflo(zc.y), s[3] * inv - bfhi(zc.y));
            o.z = pk2(s[4] * inv - bflo(zc.z), s[5] * inv - bfhi(zc.z)); o.w = pk2(s[6] * inv - bflo(zc.w), s[7] * inv - bfhi(zc.w));
            __builtin_nontemporal_store(o, (v4u*)(pooled + (size_t)(m0 + r) * D + lane * 8));
        }
    }
}

typedef short bf16x8 __attribute__((ext_vector_type(8)));
__device__ __forceinline__ f32x4 mfma16(bf16x8 x, bf16x8 y, f32x4 c) { return __builtin_amdgcn_mfma_f32_16x16x32_bf16(x, y, c, 0, 0, 0); }
constexpr int TR_STRIDE = 144;
constexpr int CH_STRIDE = 272;

__device__ __forceinline__ float fast_ln(float x) { return __builtin_amdgcn_logf(x) * 0.69314718f; }
constexpr float ST_SCALE = 8.0f, ST_INV = 1.0f / 8.0f, ST_MAX = 440.0f;
__device__ __forceinline__ float st_clamp(float x) { return fminf(fmaxf(x, -ST_MAX), ST_MAX); }
__device__ __forceinline__ unsigned pack_fp8x4(float a, float b, float c, float d) {
    int w = 0; w = __builtin_amdgcn_cvt_pk_fp8_f32(st_clamp(a), st_clamp(b), w, false); w = __builtin_amdgcn_cvt_pk_fp8_f32(st_clamp(c), st_clamp(d), w, true); return (unsigned)w; }
__device__ __forceinline__ f32x4 unpack_fp8x4(unsigned w) { const f32x2 lo = __builtin_amdgcn_cvt_pk_f32_fp8((int)w, false), hi = __builtin_amdgcn_cvt_pk_f32_fp8((int)w, true); return (f32x4){lo.x, lo.y, hi.x, hi.y}; }

__device__ __forceinline__ void hgrn_local_item(const bf16* proj, bf16* LT, float* DV, LAS unsigned char* lds, int it, int tid) {
    const int b = it >> 9, head = (it >> 7) & 3, c = it & 127;
    const int cp = tid & 63, pg = __builtin_amdgcn_readfirstlane(tid >> 6), lane = tid & 63, fr = lane & 15, fq = lane >> 4;
    LAS unsigned char* VT = lds;
    LAS unsigned char* KF = lds + 128 * TR_STRIDE;
    LAS unsigned char* KB = lds + 2 * 128 * TR_STRIDE;
    LAS float* TF = (LAS float*)(lds + 3 * 128 * TR_STRIDE);
    LAS float* TB = TF + 1024;
    const size_t row0 = (size_t)b * SEQ + c * 64 + pg * 8;
    const bf16* pv = proj + row0 * INC + 1024 + head * 128 + 2 * cp;
    const bf16* pkf = proj + row0 * INC + 1536 + head * 128 + 2 * cp;
    const bf16* pkb = pkf + 512;
    unsigned rv[8], rkf[8], rkb[8];
#pragma unroll
    for (int i = 0; i < 8; ++i) { rv[i] = __builtin_nontemporal_load((const unsigned*)(pv + (size_t)i * INC)); rkf[i] = __builtin_nontemporal_load((const unsigned*)(pkf + (size_t)i * INC)); rkb[i] = __builtin_nontemporal_load((const unsigned*)(pkb + (size_t)i * INC)); }
    float gf[8][2], gb[8][2]; float tf0 = 0.f, tf1 = 0.f, tb0 = 0.f, tb1 = 0.f;
#pragma unroll
    for (int i = 0; i < 8; ++i) { gf[i][0] = fast_ln(1.0f - bflo(rkf[i])); gf[i][1] = fast_ln(1.0f - bfhi(rkf[i])); gb[i][0] = fast_ln(1.0f - bflo(rkb[i])); gb[i][1] = fast_ln(1.0f - bfhi(rkb[i]));
        tf0 += gf[i][0]; tf1 += gf[i][1]; tb0 += gb[i][0]; tb1 += gb[i][1]; }
    *(LAS f32x2*)(TF + pg * 128 + 2 * cp) = (f32x2){tf0, tf1}; *(LAS f32x2*)(TB + pg * 128 + 2 * cp) = (f32x2){tb0, tb1};
    { v4u w0, w1;
      w0.x = (rv[0] & 0xffffu) | (rv[1] << 16); w0.y = (rv[2] & 0xffffu) | (rv[3] << 16); w0.z = (rv[4] & 0xffffu) | (rv[5] << 16); w0.w = (rv[6] & 0xffffu) | (rv[7] << 16);
      w1.x = (rv[0] >> 16) | (rv[1] & 0xffff0000u); w1.y = (rv[2] >> 16) | (rv[3] & 0xffff0000u); w1.z = (rv[4] >> 16) | (rv[5] & 0xffff0000u); w1.w = (rv[6] >> 16) | (rv[7] & 0xffff0000u);
      *(LAS v4u*)(VT + (2 * cp) * TR_STRIDE + pg * 16) = w0; *(LAS v4u*)(VT + (2 * cp + 1) * TR_STRIDE + pg * 16) = w1; }
    __syncthreads();
    float af0 = 0.f, af1 = 0.f, bb0 = 0.f, bb1 = 0.f, sf0 = 0.f, sf1 = 0.f, sb0 = 0.f, sb1 = 0.f;
#pragma unroll
    for (int p = 0; p < 8; ++p) { const f32x2 a = *(const LAS f32x2*)(TF + p * 128 + 2 * cp), bq = *(const LAS f32x2*)(TB + p * 128 + 2 * cp);
        sf0 += a.x; sf1 += a.y; sb0 += bq.x; sb1 += bq.y; if (p > pg) { af0 += a.x; af1 += a.y; } if (p < pg) { bb0 += bq.x; bb1 += bq.y; } }
    const int seqf = (b * 4 + head) * 128 + c, seqb = ((32 + b * 4 + head)) * 128 + c;
    if (pg == 0) { *(f32x2*)(DV + (size_t)seqf * 128 + 2 * cp) = (f32x2){__expf(sf0), __expf(sf1)}; *(f32x2*)(DV + (size_t)seqb * 128 + 2 * cp) = (f32x2){__expf(sb0), __expf(sb1)}; }
    { float kd[8][2];
#pragma unroll
      for (int i = 7; i >= 0; --i) { kd[i][0] = bflo(rkf[i]) * __expf(af0); kd[i][1] = bfhi(rkf[i]) * __expf(af1); af0 += gf[i][0]; af1 += gf[i][1]; }
      v4u w0, w1; w0.x = pk2(kd[0][0], kd[1][0]); w0.y = pk2(kd[2][0], kd[3][0]); w0.z = pk2(kd[4][0], kd[5][0]); w0.w = pk2(kd[6][0], kd[7][0]);
      w1.x = pk2(kd[0][1], kd[1][1]); w1.y = pk2(kd[2][1], kd[3][1]); w1.z = pk2(kd[4][1], kd[5][1]); w1.w = pk2(kd[6][1], kd[7][1]);
      *(LAS v4u*)(KF + (2 * cp) * TR_STRIDE + pg * 16) = w0; *(LAS v4u*)(KF + (2 * cp + 1) * TR_STRIDE + pg * 16) = w1;
#pragma unroll
      for (int i = 0; i < 8; ++i) { kd[i][0] = bflo(rkb[i]) * __expf(bb0); kd[i][1] = bfhi(rkb[i]) * __expf(bb1); bb0 += gb[i][0]; bb1 += gb[i][1]; }
      w0.x = pk2(kd[0][0], kd[1][0]); w0.y = pk2(kd[2][0], kd[3][0]); w0.z = pk2(kd[4][0], kd[5][0]); w0.w = pk2(kd[6][0], kd[7][0]);
      w1.x = pk2(kd[0][1], kd[1][1]); w1.y = pk2(kd[2][1], kd[3][1]); w1.z = pk2(kd[4][1], kd[5][1]); w1.w = pk2(kd[6][1], kd[7][1]);
      *(LAS v4u*)(KB + (2 * cp) * TR_STRIDE + pg * 16) = w0; *(LAS v4u*)(KB + (2 * cp + 1) * TR_STRIDE + pg * 16) = w1; }
    __syncthreads();
    { const int dir = pg >> 2, tv0 = 2 * (pg & 3); const LAS unsigned char* KD = dir ? KB : KF;
      unsigned char* out = (unsigned char*)LT + (size_t)(dir ? seqb : seqf) * 16384;
      bf16x8 y0[2], y1[2];
#pragma unroll
      for (int ks = 0; ks < 2; ++ks) { y0[ks] = *(const LAS bf16x8*)(VT + (16 * tv0 + fr) * TR_STRIDE + (32 * ks + 8 * fq) * 2); y1[ks] = *(const LAS bf16x8*)(VT + (16 * tv0 + 16 + fr) * TR_STRIDE + (32 * ks + 8 * fq) * 2); }
#pragma unroll
      for (int tk = 0; tk < 8; ++tk) { f32x4 a0 = (f32x4){0.f, 0.f, 0.f, 0.f}, a1 = a0;
#pragma unroll
          for (int ks = 0; ks < 2; ++ks) { const bf16x8 x = *(const LAS bf16x8*)(KD + (16 * tk + fr) * TR_STRIDE + (32 * ks + 8 * fq) * 2); a0 = mfma16(x, y0[ks], a0); a1 = mfma16(x, y1[ks], a1); }
          *(unsigned*)(out + (size_t)(16 * tv0 + fr) * 128 + 16 * tk + 4 * fq) = pack_fp8x4(a0[0] * ST_SCALE, a0[1] * ST_SCALE, a0[2] * ST_SCALE, a0[3] * ST_SCALE);
          *(unsigned*)(out + (size_t)(16 * tv0 + 16 + fr) * 128 + 16 * tk + 4 * fq) = pack_fp8x4(a1[0] * ST_SCALE, a1[1] * ST_SCALE, a1[2] * ST_SCALE, a1[3] * ST_SCALE); } }
    __syncthreads();
}

__device__ __forceinline__ void hgrn_state_scan(bf16* LT, const float* DV, int T, int NT) {
    for (int x = T; x < 64 * 2048; x += NT) {
        const int seqi = x >> 11, e8 = x & 2047, dir = seqi >> 5, k0 = (e8 & 15) * 8;
        unsigned char* base = (unsigned char*)LT + (size_t)seqi * 128 * 16384 + e8 * 8; const float* dbase = DV + (size_t)seqi * 128 * 128 + k0;
        f32x4 S0 = (f32x4){0.f, 0.f, 0.f, 0.f}, S1 = S0;
        for (int cc = 0; cc < 128; cc += 8) {
            v2u L[8]; f32x4 d0[8], d1[8];
#pragma unroll
            for (int j = 0; j < 8; ++j) { const int c = dir ? (127 - cc - j) : (cc + j); L[j] = __builtin_nontemporal_load((const v2u*)(base + (size_t)c * 16384)); d0[j] = *(const f32x4*)(dbase + c * 128); d1[j] = *(const f32x4*)(dbase + c * 128 + 4); }
#pragma unroll
            for (int j = 0; j < 8; ++j) { const int c = dir ? (127 - cc - j) : (cc + j);
                *(v2u*)(base + (size_t)c * 16384) = (v2u){pack_fp8x4(S0[0], S0[1], S0[2], S0[3]), pack_fp8x4(S1[0], S1[1], S1[2], S1[3])};
                S0 = d0[j] * S0 + unpack_fp8x4(L[j].x); S1 = d1[j] * S1 + unpack_fp8x4(L[j].y); }
        }
    }
}

__device__ __forceinline__ void hgrn_out_item(const bf16* proj, const bf16* LT, const float* gnorm, bf16* ymix, LAS unsigned char* lds, int it, int tid) {
    const int b = it >> 9, head = (it >> 7) & 3, c = it & 127;
    const int cp = tid & 63, pg = __builtin_amdgcn_readfirstlane(tid >> 6), lane = tid & 63, fr = lane & 15, fq = lane >> 4;
    LAS unsigned char* QT = lds;
    LAS unsigned char* KT = lds + 64 * CH_STRIDE;
    LAS unsigned char* VT = lds + 128 * CH_STRIDE;
    LAS unsigned char* PP = VT + 128 * TR_STRIDE;
    LAS unsigned char* ST = PP + 64 * TR_STRIDE;
    LAS float* TF = (LAS float*)(ST + 128 * CH_STRIDE);
    LAS float* TB = TF + 1024;
    LAS float* RS = TB + 1024;
    const size_t row0 = (size_t)b * SEQ + c * 64 + pg * 8;
    const bf16* pq = proj + row0 * INC + 512 + head * 128 + 2 * cp;
    unsigned rq[8], rv[8], rkf[8], rkb[8];
#pragma unroll
    for (int i = 0; i < 8; ++i) { rq[i] = __builtin_nontemporal_load((const unsigned*)(pq + (size_t)i * INC)); rv[i] = __builtin_nontemporal_load((const unsigned*)(pq + (size_t)i * INC + 512)); rkf[i] = __builtin_nontemporal_load((const unsigned*)(pq + (size_t)i * INC + 1024)); rkb[i] = __builtin_nontemporal_load((const unsigned*)(pq + (size_t)i * INC + 1536)); }
    { float tf0 = 0.f, tf1 = 0.f, tb0 = 0.f, tb1 = 0.f;
#pragma unroll
      for (int i = 0; i < 8; ++i) { tf0 += fast_ln(1.0f - bflo(rkf[i])); tf1 += fast_ln(1.0f - bfhi(rkf[i])); tb0 += fast_ln(1.0f - bflo(rkb[i])); tb1 += fast_ln(1.0f - bfhi(rkb[i])); }
      *(LAS f32x2*)(TF + pg * 128 + 2 * cp) = (f32x2){tf0, tf1}; *(LAS f32x2*)(TB + pg * 128 + 2 * cp) = (f32x2){tb0, tb1};
      v4u w0, w1;
      w0.x = (rv[0] & 0xffffu) | (rv[1] << 16); w0.y = (rv[2] & 0xffffu) | (rv[3] << 16); w0.z = (rv[4] & 0xffffu) | (rv[5] << 16); w0.w = (rv[6] & 0xffffu) | (rv[7] << 16);
      w1.x = (rv[0] >> 16) | (rv[1] & 0xffff0000u); w1.y = (rv[2] >> 16) | (rv[3] & 0xffff0000u); w1.z = (rv[4] >> 16) | (rv[5] & 0xffff0000u); w1.w = (rv[6] >> 16) | (rv[7] & 0xffff0000u);
      *(LAS v4u*)(VT + (2 * cp) * TR_STRIDE + pg * 16) = w0; *(LAS v4u*)(VT + (2 * cp + 1) * TR_STRIDE + pg * 16) = w1; }
    __syncthreads();
    const int ti = pg & 3, hv = pg >> 2;
    f32x4 acc[4];
#pragma unroll
    for (int t = 0; t < 4; ++t) acc[t] = (f32x4){0.f, 0.f, 0.f, 0.f};
#pragma unroll
    for (int dir = 0; dir < 2; ++dir) {
        { const LAS float* TT = dir ? TB : TF; float o0 = 0.f, o1 = 0.f;
#pragma unroll
          for (int p = 0; p < 8; ++p) { const f32x2 a = *(const LAS f32x2*)(TT + p * 128 + 2 * cp); if (dir ? (p > pg) : (p < pg)) { o0 += a.x; o1 += a.y; } }
#pragma unroll
          for (int ii = 0; ii < 8; ++ii) { const int i = dir ? (7 - ii) : ii; const unsigned rk = dir ? rkb[i] : rkf[i];
              const float k0 = bflo(rk), k1 = bfhi(rk); o0 += fast_ln(1.0f - k0); o1 += fast_ln(1.0f - k1);
              const float e0 = __expf(o0), e1 = __expf(o1), n0 = __expf(-o0), n1 = __expf(-o1);
              *(LAS unsigned*)(QT + (8 * pg + i) * CH_STRIDE + 4 * cp) = pk2(bflo(rq[i]) * e0, bfhi(rq[i]) * e1);
              *(LAS unsigned*)(KT + (8 * pg + i) * CH_STRIDE + 4 * cp) = pk2(k0 * n0, k1 * n1); }
          const unsigned char* Sg = (const unsigned char*)LT + ((size_t)((dir * 32 + b * 4 + head) * 128 + c)) * 16384;
          v4u raw[2];
#pragma unroll
          for (int i = 0; i < 2; ++i) raw[i] = __builtin_nontemporal_load((const v4u*)(Sg + (size_t)(tid + 512 * i) * 16));
#pragma unroll
          for (int i = 0; i < 2; ++i) { const int e = tid + 512 * i; const f32x4 f0 = unpack_fp8x4(raw[i].x) * ST_INV, f1 = unpack_fp8x4(raw[i].y) * ST_INV, f2 = unpack_fp8x4(raw[i].z) * ST_INV, f3 = unpack_fp8x4(raw[i].w) * ST_INV;
              LAS v4u* dst = (LAS v4u*)(ST + (e >> 3) * CH_STRIDE + (e & 7) * 32);
              dst[0] = (v4u){pk2(f0[0], f0[1]), pk2(f0[2], f0[3]), pk2(f1[0], f1[1]), pk2(f1[2], f1[3])};
              dst[1] = (v4u){pk2(f2[0], f2[1]), pk2(f2[2], f2[3]), pk2(f3[0], f3[1]), pk2(f3[2], f3[3])}; } }
        __syncthreads();
        { bf16x8 yq[4];
#pragma unroll
          for (int ks = 0; ks < 4; ++ks) yq[ks] = *(const LAS bf16x8*)(QT + (16 * ti + fr) * CH_STRIDE + (32 * ks + 8 * fq) * 2);
#pragma unroll
          for (int jj = 0; jj < 2; ++jj) { const int tj = 2 * hv + jj; f32x4 s = (f32x4){0.f, 0.f, 0.f, 0.f};
              if (dir ? (tj >= ti) : (tj <= ti)) {
#pragma unroll
                  for (int ks = 0; ks < 4; ++ks) { const bf16x8 x = *(const LAS bf16x8*)(KT + (16 * tj + fr) * CH_STRIDE + (32 * ks + 8 * fq) * 2); s = mfma16(x, yq[ks], s); }
                  const int ipos = 16 * ti + fr, j0 = 16 * tj + 4 * fq;
#pragma unroll
                  for (int e = 0; e < 4; ++e) { const bool keep = dir ? (j0 + e >= ipos) : (j0 + e <= ipos); s[e] = keep ? s[e] : 0.f; } }
              *(LAS v2u*)(PP + (16 * ti + fr) * TR_STRIDE + (16 * tj + 4 * fq) * 2) = (v2u){pk2(s[0], s[1]), pk2(s[2], s[3])}; }
          __syncthreads();
          bf16x8 yp[2];
#pragma unroll
          for (int ks = 0; ks < 2; ++ks) yp[ks] = *(const LAS bf16x8*)(PP + (16 * ti + fr) * TR_STRIDE + (32 * ks + 8 * fq) * 2);
#pragma unroll
          for (int t = 0; t < 4; ++t) { const int tv = 4 * hv + t;
#pragma unroll
              for (int ks = 0; ks < 4; ++ks) { const bf16x8 x = *(const LAS bf16x8*)(ST + (16 * tv + fr) * CH_STRIDE + (32 * ks + 8 * fq) * 2); acc[t] = mfma16(x, yq[ks], acc[t]); }
#pragma unroll
              for (int ks = 0; ks < 2; ++ks) { const bf16x8 x = *(const LAS bf16x8*)(VT + (16 * tv + fr) * TR_STRIDE + (32 * ks + 8 * fq) * 2); acc[t] = mfma16(x, yp[ks], acc[t]); } } }
        __syncthreads();
    }
    float ss = 0.f;
#pragma unroll
    for (int t = 0; t < 4; ++t) ss += (acc[t][0] * acc[t][0] + acc[t][1] * acc[t][1]) + (acc[t][2] * acc[t][2] + acc[t][3] * acc[t][3]);
    ss += __shfl_xor(ss, 16); ss += __shfl_xor(ss, 32);
    if (fq == 0) RS[hv * 64 + 16 * ti + fr] = ss;
    __syncthreads();
    const float r = __builtin_amdgcn_rsqf((RS[16 * ti + fr] + RS[64 + 16 * ti + fr]) * (1.0f / 128.0f) + EPS);
    const size_t row = (size_t)b * SEQ + c * 64 + 16 * ti + fr;
#pragma unroll
    for (int t = 0; t < 4; ++t) { const int vcol = 64 * hv + 16 * t + 4 * fq; const f32x4 gn = *(const f32x4*)(gnorm + vcol);
        const v2u gz = __builtin_nontemporal_load((const v2u*)(proj + row * INC + 2560 + head * 128 + vcol));
        *(v2u*)(ymix + row * D + 512 + head * 128 + vcol) = (v2u){pk2(acc[t][0] * r * gn[0] * bflo(gz.x), acc[t][1] * r * gn[1] * bfhi(gz.x)), pk2(acc[t][2] * r * gn[2] * bflo(gz.y), acc[t][3] * r * gn[3] * bfhi(gz.y))}; }
}

__device__ __forceinline__ void final_norm(const bf16* hb, float* out, const float* ssq3, const float* wf, int gw, int NGW, int lane) {
    f32x4 w4[4];
#pragma unroll
    for (int j = 0; j < 2; ++j) { w4[2 * j] = *(const f32x4*)(wf + 512 * j + lane * 8); w4[2 * j + 1] = *(const f32x4*)(wf + 512 * j + lane * 8 + 4); }
    for (int m = gw; m < M; m += NGW) {
        const float r = __builtin_amdgcn_rsqf(ssq3[m] * (1.0f / 1024.0f) + EPS);
        const v4u h0 = __builtin_nontemporal_load((const v4u*)(hb + (size_t)m * D + lane * 8)), h1 = __builtin_nontemporal_load((const v4u*)(hb + (size_t)m * D + 512 + lane * 8));
        float* o = out + (size_t)m * D + lane * 8;
        __builtin_nontemporal_store((f32x4){bflo(h0.x), bfhi(h0.x), bflo(h0.y), bfhi(h0.y)} * r * w4[0], (f32x4*)(o));
        __builtin_nontemporal_store((f32x4){bflo(h0.z), bfhi(h0.z), bflo(h0.w), bfhi(h0.w)} * r * w4[1], (f32x4*)(o + 4));
        __builtin_nontemporal_store((f32x4){bflo(h1.x), bfhi(h1.x), bflo(h1.y), bfhi(h1.y)} * r * w4[2], (f32x4*)(o + 512));
        __builtin_nontemporal_store((f32x4){bflo(h1.z), bfhi(h1.z), bflo(h1.w), bfhi(h1.w)} * r * w4[3], (f32x4*)(o + 516));
    }
}

__global__ void __launch_bounds__(NWAVES * 64, 2) mk_fwd(Args args) {
    extern __shared__ __attribute__((aligned(16))) unsigned char lds_raw[];
    cg::grid_group grid = cg::this_grid();
    LAS unsigned char* lds = (LAS unsigned char*)lds_raw;
    const int tid = threadIdx.x, lane = tid & 63, wave = __builtin_amdgcn_readfirstlane(tid >> 6);
    const int G = gridDim.x, bx = blockIdx.x;
    const int vcu = (G % 8 == 0) ? (bx % 8) * (G / 8) + bx / 8 : bx;
    const int gw = vcu * NWAVES + wave, NGW = G * NWAVES;
    unsigned char* ws = args.ws;
    float* ssq = (float*)(ws + WS_SSQ);
    bf16* actb = (bf16*)(ws + WS_ACTB); bf16* ymix = (bf16*)(ws + WS_YMIX); bf16* proj = (bf16*)(ws + WS_PROJ); bf16* hid = (bf16*)(ws + WS_PROJ);
    bf16* LT = (bf16*)(ws + WS_LT); float* DV = args.out; bf16* pooled = (bf16*)(ws + WS_POOLED);

    volatile LAS unsigned* MISC = (volatile LAS unsigned*)(lds + 131072 + 320);
    if (tid < 32) MISC[tid] = 0u;
    __syncthreads();
    const XcdBarrier bar = xcd_barrier_post((unsigned*)(ws + WS_BAR), MISC + 8);
    p0_prologue(args, lds, gw, NGW, wave, lane);
    if (args.ws == nullptr) grid.sync();
    xcd_barrier(bar);
#define FFN_UP(h, WGU, SSQIN) { pg8::Gemm g{actb + (size_t)(h) * MH * D, (const bf16*)(ws + (WGU)), MH, 2 * FF, D}; pg8::StaticOrder S; S.init(MH, 2 * FF, G, bx); \
      pg8::EpiSwiglu E{hid + (size_t)(h) * MH * FF, FF, (SSQIN) + (h) * MH}; pg8::gemm_phase<pg8::EpiSwiglu, pg8::StaticOrder, true, true>(lds, g, S, E); }
#define FFN_DOWN(h, WD, SSQOUT) { pg8::Gemm g{hid + (size_t)(h) * MH * FF, (const bf16*)(ws + (WD)), MH, D, FF}; pg8::StaticOrder S; S.init(MH, D, G, bx, 1); \
      pg8::EpiResid E{actb + (size_t)(h) * MH * D, (SSQOUT) + (h) * MH, 0.5f, D}; pg8::gemm_phase<pg8::EpiResid, pg8::StaticOrder, true, true>(lds, g, S, E); }
    constexpr int MH = M / 2;
    FFN_UP(0, WS_WGU1, ssq)
    xcd_barrier(bar);
    FFN_DOWN(0, WS_WD1, ssq + M)
    FFN_UP(1, WS_WGU1, ssq)
    xcd_barrier(bar);
    FFN_DOWN(1, WS_WD1, ssq + M)
    xcd_barrier(bar);
    { pg8::Gemm g{actb, (const bf16*)(ws + WS_WIN), M, INC, D}; pg8::StaticOrder S; S.init(M, INC, G, bx);
      pg8::EpiProj E{proj, INC, ssq + M, (const float*)(ws + WS_OMLB)};
      pg8::gemm_phase<pg8::EpiProj, pg8::StaticOrder, true, true>(lds, g, S, E); }
    xcd_barrier(bar);
    pool_rows(proj, ymix, gw, NGW, lane);
    for (int it = bx; it < 4096; it += G) hgrn_local_item(proj, LT, DV, lds, it, tid);
    xcd_barrier(bar);
    hgrn_state_scan(LT, DV, bx * (NWAVES * 64) + tid, G * NWAVES * 64);
    xcd_barrier(bar);
    for (int it = bx; it < 4096; it += G) hgrn_out_item(proj, LT, args.in[10], ymix, lds, it, tid);
    xcd_barrier(bar);
    { pg8::Gemm g{ymix, (const bf16*)(ws + WS_WOUT), M, D, D}; pg8::StaticOrder S; S.init(M, D, G, bx);
      pg8::EpiResid E{actb, ssq + 2 * M, 1.0f, D};
      pg8::gemm_phase<pg8::EpiResid, pg8::StaticOrder, true, true>(lds, g, S, E); }
    xcd_barrier(bar);
    FFN_UP(0, WS_WGU2, ssq + 2 * M)
    xcd_barrier(bar);
    FFN_DOWN(0, WS_WD2, ssq + 3 * M)
    FFN_UP(1, WS_WGU2, ssq + 2 * M)
    xcd_barrier(bar);
    FFN_DOWN(1, WS_WD2, ssq + 3 * M)
    xcd_barrier(bar);
#undef FFN_UP
#undef FFN_DOWN
    final_norm(actb, args.out, ssq + 3 * M, args.in[16], gw, NGW, lane);
}

extern "C" void kernel_launch(void* const* d_in, const int* in_sizes, int n_in, void* d_out, int out_size, void* d_ws, size_t ws_size, hipStream_t stream) {
    static int grid = 0;
    if (grid == 0) {
        if (n_in != 17 || in_sizes[0] != M * D || out_size != M * D || ws_size < WS_END) { fprintf(stderr, "kernel_launch: unexpected shapes: n_in %d in0 %d out %d ws %zu\n", n_in, n_in > 0 ? in_sizes[0] : -1, out_size, ws_size); grid = -1; return; }
        int dev = 0, cus = 0, per_cu = 0;
        if (hipGetDevice(&dev) != hipSuccess || hipDeviceGetAttribute(&cus, hipDeviceAttributeMultiprocessorCount, dev) != hipSuccess) { grid = -1; return; }
        if (hipFuncSetAttribute((const void*)mk_fwd, hipFuncAttributeMaxDynamicSharedMemorySize, LDS_BYTES) != hipSuccess) { fprintf(stderr, "kernel_launch: hipFuncSetAttribute failed\n"); grid = -1; return; }
        if (hipOccupancyMaxActiveBlocksPerMultiprocessor(&per_cu, (const void*)mk_fwd, NWAVES * 64, LDS_BYTES) != hipSuccess || per_cu < 1) { fprintf(stderr, "kernel_launch: occupancy query says %d\n", per_cu); per_cu = 1; }
        (void)hipGetLastError();
        grid = cus * 1;
    }
    if (grid < 0) return;
    if (hipMemsetAsync((char*)d_ws + WS_BAR, 0, 16384, stream) != hipSuccess) { fprintf(stderr, "kernel_launch: memset of barrier words failed\n"); return; }
    Args a{};
    for (int i = 0; i < 17; ++i) a.in[i] = (const float*)d_in[i];
    a.out = (float*)d_out; a.ws = (unsigned char*)d_ws;
    void* kargs[] = {&a};
    hipError_t e = hipLaunchCooperativeKernel((const void*)mk_fwd, dim3(grid), dim3(NWAVES * 64), kargs, LDS_BYTES, stream);
    if (e != hipSuccess) fprintf(stderr, "kernel_launch: cooperative launch failed: %s (grid %d)\n", hipGetErrorString(e), grid);
}
```

```cpp
#include <hip/hip_runtime.h>
#include <hip/hip_cooperative_groups.h>
#include <cstdio>
#include <cstdint>
namespace cg = cooperative_groups;
namespace pg8 {
#define PG8_LAS __attribute__((address_space(3)))
typedef unsigned short bf16_t;
typedef short bf16x8 __attribute__((ext_vector_type(8)));
typedef float f32x4 __attribute__((ext_vector_type(4)));
typedef unsigned u32x4 __attribute__((ext_vector_type(4)));
constexpr int BM = 256, BK = 64, HALF = 128, HTB = HALF * BK * 2  , STAGE_BYTES = 8 * HTB, NXCD = 8, WGM = 8;

__host__ __device__ __forceinline__ int lds_byte(int r, int c) { const int st = (r >> 4) * 2 + (c >> 5), rr = r & 15, cc = c & 31, ob = rr * 64 + cc * 2; return st * 1024 + (ob ^ (((ob >> 9) & 1) << 5)); }
__host__ __device__ __forceinline__ void stage_rc(int b, int& R, int& C) { const int st = b / 1024, sb = b % 1024, swz = sb ^ (((sb >> 9) & 1) << 5); R = (st >> 1) * 16 + swz / 64; C = (st & 1) * 32 + (swz % 64) / 2; }
__host__ __device__ __forceinline__ int perm32(int rho) { const int n = rho >> 4, i = rho & 15; return 8 * (i >> 2) + 4 * n + (i & 3); }

struct Unit { int pm, pn; };
struct Gemm { const bf16_t* A; const bf16_t* Bt; int M, N, K; };

struct StaticOrder {
    int nM, nN, nwg, G, c, rev;
    __host__ __device__ void init(int M, int N, int G_, int c_, int rev_ = 0) { nM = M / BM; nN = N / BM; nwg = nM * nN; G = G_; c = c_; rev = rev_; }
    __host__ __device__ bool next(int i, Unit& u) const {
        const long L = (long)i * G + c; if (L >= nwg) return false;
        int wgid = (int)L; { const int q = nwg / NXCD, r = nwg % NXCD, xcd = wgid % NXCD; int off = wgid / NXCD; if (rev && r == 0) off = q - 1 - off; wgid = (xcd < r ? xcd * (q + 1) : r * (q + 1) + (xcd - r) * q) + off; }
        const int nig = WGM * nN, gid = wgid / nig, fm = gid * WGM, gsz = (nM - fm) < WGM ? (nM - fm) : WGM;
        u.pm = fm + ((wgid % nig) % gsz); u.pn = (wgid % nig) / gsz; return true;
    }
    __device__ __forceinline__ void a_ready(const Unit&) const {}
    __device__ __forceinline__ void done(const Unit&) const {}
};
typedef float f32x2 __attribute__((ext_vector_type(2)));
typedef __bf16 bf16x2_t __attribute__((ext_vector_type(2)));
__device__ __forceinline__ unsigned cvt_pk_bf16(float lo, float hi) { f32x2 v = {lo, hi}; bf16x2_t b = __builtin_convertvector(v, bf16x2_t); return __builtin_bit_cast(unsigned, b); }

constexpr float RMS_EPS = 1e-6f;
__device__ __forceinline__ float fast_sigmoid(float v) { return __builtin_amdgcn_rcpf(1.0f + __expf(-v)); }
__device__ __forceinline__ float silu_f(float v) { return v * fast_sigmoid(v); }

struct EpiSwiglu {
    static constexpr bool PERM = true, AFTER_DRAIN = false;
    bf16_t* O; int ldc; const float* ssq;
    __device__ __forceinline__ void operator()(const f32x4 (&acc)[2][2][4][2], const Unit& u, int wr, int wc, int fr, int fq) const {
        const int row0 = u.pm * BM + wr * 64 + fr, col0 = u.pn * HALF + wc * 32 + 8 * fq;
#pragma unroll
        for (int ai = 0; ai < 2; ++ai)
#pragma unroll
            for (int m = 0; m < 4; ++m) { const int row = row0 + ai * HALF + m * 16;
                const float r = __builtin_amdgcn_rsqf(ssq[row] * (1.0f / 1024.0f) + RMS_EPS);
                float h[8];
#pragma unroll
                for (int n = 0; n < 2; ++n)
#pragma unroll
                    for (int e = 0; e < 4; ++e) { const float g = acc[ai][0][m][n][e] * r, up = acc[ai][1][m][n][e] * r; h[4 * n + e] = silu_f(g) * up; }
                u32x4 w; w.x = cvt_pk_bf16(h[0], h[1]); w.y = cvt_pk_bf16(h[2], h[3]); w.z = cvt_pk_bf16(h[4], h[5]); w.w = cvt_pk_bf16(h[6], h[7]);
                *(u32x4*)(O + (size_t)row * ldc + col0) = w; }
    }
};
struct EpiResid {
    static constexpr bool PERM = true, AFTER_DRAIN = false;
    bf16_t* hb; float* ssq_out; float scale; int ldc;
    __device__ __forceinline__ void operator()(const f32x4 (&acc)[2][2][4][2], const Unit& u, int wr, int wc, int fr, int fq) const {
        const int row0 = u.pm * BM + wr * 64 + fr, col0 = u.pn * BM + wc * 32 + 8 * fq;
#pragma unroll
        for (int ai = 0; ai < 2; ++ai)
#pragma unroll
            for (int m = 0; m < 4; ++m) { const int row = row0 + ai * HALF + m * 16; const size_t off = (size_t)row * ldc + col0; float s = 0.f;
                u32x4 bw[2];
#pragma unroll
                for (int bj = 0; bj < 2; ++bj) bw[bj] = *(const u32x4*)(hb + off + bj * HALF);
#pragma unroll
                for (int bj = 0; bj < 2; ++bj) {
                    const f32x4 b0 = (f32x4){__uint_as_float(bw[bj].x << 16), __uint_as_float(bw[bj].x & 0xffff0000u), __uint_as_float(bw[bj].y << 16), __uint_as_float(bw[bj].y & 0xffff0000u)};
                    const f32x4 b1 = (f32x4){__uint_as_float(bw[bj].z << 16), __uint_as_float(bw[bj].z & 0xffff0000u), __uint_as_float(bw[bj].w << 16), __uint_as_float(bw[bj].w & 0xffff0000u)};
                    const f32x4 v0 = b0 + acc[ai][bj][m][0] * scale, v1 = b1 + acc[ai][bj][m][1] * scale;
                    u32x4 w; w.x = cvt_pk_bf16(v0[0], v0[1]); w.y = cvt_pk_bf16(v0[2], v0[3]); w.z = cvt_pk_bf16(v1[0], v1[1]); w.w = cvt_pk_bf16(v1[2], v1[3]);
                    *(u32x4*)(hb + off + bj * HALF) = w;
                    s += (v0[0] * v0[0] + v0[1] * v0[1]) + (v0[2] * v0[2] + v0[3] * v0[3]) + (v1[0] * v1[0] + v1[1] * v1[1]) + (v1[2] * v1[2] + v1[3] * v1[3]); }
                s += __shfl_xor(s, 16); s += __shfl_xor(s, 32);
                if (fq == 0) unsafeAtomicAdd(ssq_out + row, s); }
    }
};
struct EpiProj {
    static constexpr bool PERM = true, AFTER_DRAIN = false;
    bf16_t* O; int ldc; const float* ssq; const float* omlb;
    __device__ __forceinline__ void operator()(const f32x4 (&acc)[2][2][4][2], const Unit& u, int wr, int wc, int fr, int fq) const {
        const int row0 = u.pm * BM + wr * 64 + fr, col0 = u.pn * BM + wc * 32 + 8 * fq; const int type = u.pn >> 1;
        float ol[2][8];
#pragma unroll
        for (int bj = 0; bj < 2; ++bj)
#pragma unroll
            for (int e = 0; e < 8; ++e) ol[bj][e] = (type == 3 || type == 4) ? omlb[col0 + bj * HALF + e - 1536] : 0.f;
#pragma unroll
        for (int ai = 0; ai < 2; ++ai)
#pragma unroll
            for (int m = 0; m < 4; ++m) { const int row = row0 + ai * HALF + m * 16;
                const float r = __builtin_amdgcn_rsqf(ssq[row] * (1.0f / 1024.0f) + RMS_EPS);
#pragma unroll
                for (int bj = 0; bj < 2; ++bj) { float h[8];
#pragma unroll
                    for (int n = 0; n < 2; ++n)
#pragma unroll
                        for (int e = 0; e < 4; ++e) { const float v = acc[ai][bj][m][n][e] * r; float o = v;
                            if (type == 1 || type == 5) o = silu_f(v);
                            if (type == 3 || type == 4) o = ol[bj][4 * n + e] * __builtin_amdgcn_rcpf(1.0f + __expf(v));
                            h[4 * n + e] = o; }
                    u32x4 w; w.x = cvt_pk_bf16(h[0], h[1]); w.y = cvt_pk_bf16(h[2], h[3]); w.z = cvt_pk_bf16(h[4], h[5]); w.w = cvt_pk_bf16(h[6], h[7]);
                    u32x4* dst = (u32x4*)(O + (size_t)row * ldc + col0 + bj * HALF);
                    if (type == 1 || type == 5) __builtin_nontemporal_store(w, dst); else *dst = w; } }
    }
};
struct EpiPlain {
    static constexpr bool PERM = true, AFTER_DRAIN = false;
    bf16_t* O; int ldc;
    __device__ __forceinline__ void operator()(const f32x4 (&acc)[2][2][4][2], const Unit& u, int wr, int wc, int fr, int fq) const {
        const int row0 = u.pm * BM + wr * 64 + fr, col0 = u.pn * BM + wc * 32 + 8 * fq;
#pragma unroll
        for (int ai = 0; ai < 2; ++ai)
#pragma unroll
            for (int m = 0; m < 4; ++m) { const int row = row0 + ai * HALF + m * 16;
#pragma unroll
                for (int bj = 0; bj < 2; ++bj) { const f32x4 v0 = acc[ai][bj][m][0], v1 = acc[ai][bj][m][1];
                    u32x4 w; w.x = cvt_pk_bf16(v0[0], v0[1]); w.y = cvt_pk_bf16(v0[2], v0[3]); w.z = cvt_pk_bf16(v1[0], v1[1]); w.w = cvt_pk_bf16(v1[2], v1[3]);
                    *(u32x4*)(O + (size_t)row * ldc + col0 + bj * HALF) = w; } }
    }
};

template <class Epi, class Sched, bool ALIGN_EPI = false, bool SP2 = false>
__device__ __forceinline__ void gemm_phase(PG8_LAS unsigned char* lds, const Gemm g, const Sched& S, const Epi& E) {
    const int tid = threadIdx.x, wid = __builtin_amdgcn_readfirstlane(tid >> 6), lane = tid & 63, wr = wid >> 2, wc = wid & 3, fr = lane & 15, fq = lane >> 4;
    const int K = g.K, nt = K / BK;
    unsigned voffA[2], voffB[2];
#pragma unroll
    for (int i = 0; i < 2; ++i) { int R, C; stage_rc(tid * 16 + i * 8192, R, C); const int Rb = Epi::PERM ? ((R & ~31) + perm32(R & 31)) : R;
        voffA[i] = (unsigned)(R * K + C) * 2u; voffB[i] = (unsigned)(Rb * K + C) * 2u; }
    const size_t kstep = (size_t)(BK * 2);
    const size_t hstep = (size_t)HALF * K * 2;
    const size_t tstep = 2 * hstep;
    const unsigned ldsw = (unsigned)wid * 1024u;
    const int aoff = lds_byte(wr * 64 + fr, fq * 8), boff = lds_byte(wc * 32 + fr, fq * 8);
#define PG8_SA(b, h) (((b) * 2 + (h)) * HTB)
#define PG8_SB(b, h) ((4 + (b) * 2 + (h)) * HTB)
#define PG8_STAGE(bufoff, gbase, voff) do { _Pragma("unroll") for (int _i = 0; _i < 2; ++_i) \
        __builtin_amdgcn_global_load_lds((const unsigned*)((const char*)(gbase) + (voff)[_i]), (PG8_LAS unsigned*)(lds + (bufoff) + ldsw + _i * 8192), 16, 0, 0); } while (0)
#define PG8_LDA(dst, b, h) do { _Pragma("unroll") for (int m = 0; m < 4; ++m) _Pragma("unroll") for (int k = 0; k < 2; ++k) dst[m][k] = *(const PG8_LAS bf16x8*)(lds + PG8_SA(b, h) + aoff + m * 2048 + k * 1024); } while (0)
#define PG8_LDB(dst, b, h) do { _Pragma("unroll") for (int n = 0; n < 2; ++n) _Pragma("unroll") for (int k = 0; k < 2; ++k) dst[n][k] = *(const PG8_LAS bf16x8*)(lds + PG8_SB(b, h) + boff + n * 2048 + k * 1024); } while (0)
#define PG8_MMA(ai, bj, At, Bt) do { __builtin_amdgcn_s_setprio(1); _Pragma("unroll") for (int m = 0; m < 4; ++m) _Pragma("unroll") for (int n = 0; n < 2; ++n) _Pragma("unroll") for (int k = 0; k < 2; ++k) \
        acc[ai][bj][m][n] = __builtin_amdgcn_mfma_f32_16x16x32_bf16(Bt[n][k], At[m][k], acc[ai][bj][m][n], 0, 0, 0); __builtin_amdgcn_s_setprio(0); } while (0)
#define PG8_WAIT_V(n) asm volatile("s_waitcnt vmcnt(" #n ")" ::: "memory")
#define PG8_WAIT_L(n) asm volatile("s_waitcnt lgkmcnt(" #n ")" ::: "memory")
#define PG8_BAR __builtin_amdgcn_s_barrier()
#define PG8_SCHED __builtin_amdgcn_sched_barrier(0)
    Unit cur, nxt; int ui = 0;
    if (!S.next(0, cur)) return;
    f32x4 acc[2][2][4][2];
#pragma unroll
    for (int a = 0; a < 2; ++a)
#pragma unroll
        for (int b = 0; b < 2; ++b)
#pragma unroll
            for (int m = 0; m < 4; ++m)
#pragma unroll
                for (int n = 0; n < 2; ++n) acc[a][b][m][n] = (f32x4){0.f, 0.f, 0.f, 0.f};
    bf16x8 At[4][2], B0[2][2], B1[2][2];
    const char* cA = (const char*)g.A + (size_t)cur.pm * tstep; const char* cB = (const char*)g.Bt + (size_t)cur.pn * tstep;
    S.a_ready(cur);
    if constexpr (SP2) {
        PG8_STAGE(PG8_SB(0, 0), cB, voffB); PG8_STAGE(PG8_SB(0, 1), cB + hstep, voffB); PG8_STAGE(PG8_SA(0, 0), cA, voffA); PG8_STAGE(PG8_SA(0, 1), cA + hstep, voffA);
        if (wr == 1) PG8_BAR;
        PG8_WAIT_V(2); PG8_BAR;
        PG8_STAGE(PG8_SB(1, 0), cB + kstep, voffB); PG8_STAGE(PG8_SA(1, 0), cA + kstep, voffA); PG8_STAGE(PG8_SB(1, 1), cB + hstep + kstep, voffB);
        PG8_WAIT_V(6); PG8_BAR;
    } else {
        PG8_STAGE(PG8_SB(0, 0), cB, voffB); PG8_STAGE(PG8_SA(0, 0), cA, voffA); PG8_STAGE(PG8_SB(0, 1), cB + hstep, voffB); PG8_STAGE(PG8_SA(0, 1), cA + hstep, voffA);
        if (wr == 1) PG8_BAR;
        PG8_WAIT_V(4); PG8_BAR;
        PG8_STAGE(PG8_SB(1, 0), cB + kstep, voffB); PG8_STAGE(PG8_SA(1, 0), cA + kstep, voffA); PG8_STAGE(PG8_SB(1, 1), cB + hstep + kstep, voffB);
        PG8_WAIT_V(6); PG8_BAR;
    }
    for (;;) {
        const bool has_next = S.next(ui + 1, nxt);
        const char* nA = has_next ? (const char*)g.A + (size_t)nxt.pm * tstep : cA; const char* nB = has_next ? (const char*)g.Bt + (size_t)nxt.pn * tstep : cB;
        for (int t = 0; t < nt; t += 2) {
            const bool last = (t == nt - 2);
            const char* a1 = cA + (size_t)(t + 1) * kstep;
            const char* a2 = last ? nA : cA + (size_t)(t + 2) * kstep; const char* b2 = last ? nB : cB + (size_t)(t + 2) * kstep;
            const char* a3 = a2 + kstep; const char* b3 = b2 + kstep;
            if (last && has_next) S.a_ready(nxt);
            if constexpr (SP2) {
            PG8_LDB(B0, 0, 0); PG8_LDB(B1, 0, 1); PG8_SCHED; PG8_LDA(At, 0, 0); PG8_STAGE(PG8_SA(1, 1), a1 + hstep, voffA);
            PG8_WAIT_V(8); PG8_WAIT_L(0); PG8_BAR; PG8_MMA(0, 0, At, B0); PG8_MMA(0, 1, At, B1); PG8_BAR; PG8_SCHED;
            PG8_LDA(At, 0, 1); PG8_STAGE(PG8_SB(0, 0), b2, voffB); PG8_STAGE(PG8_SB(0, 1), b2 + hstep, voffB); PG8_STAGE(PG8_SA(0, 0), a2, voffA);
            PG8_WAIT_V(8); PG8_WAIT_L(0); PG8_BAR; PG8_MMA(1, 0, At, B0); PG8_MMA(1, 1, At, B1); PG8_BAR; PG8_SCHED;
            PG8_LDB(B0, 1, 0); PG8_LDB(B1, 1, 1); PG8_SCHED; PG8_LDA(At, 1, 0); PG8_STAGE(PG8_SA(0, 1), a2 + hstep, voffA);
            PG8_WAIT_V(8); PG8_WAIT_L(0); PG8_BAR; PG8_MMA(0, 0, At, B0); PG8_MMA(0, 1, At, B1); PG8_BAR; PG8_SCHED;
            PG8_LDA(At, 1, 1); PG8_STAGE(PG8_SB(1, 0), b3, voffB); PG8_STAGE(PG8_SB(1, 1), b3 + hstep, voffB); PG8_STAGE(PG8_SA(1, 0), a3, voffA);
            PG8_WAIT_V(8); PG8_WAIT_L(0); PG8_BAR; PG8_MMA(1, 0, At, B0); PG8_MMA(1, 1, At, B1); PG8_BAR; PG8_SCHED;
            } else {
            PG8_LDB(B0, 0, 0); PG8_SCHED; PG8_LDA(At, 0, 0); PG8_STAGE(PG8_SA(1, 1), a1 + hstep, voffA);
            PG8_WAIT_L(8); PG8_BAR; PG8_WAIT_L(0); PG8_MMA(0, 0, At, B0); PG8_BAR; PG8_SCHED;
            PG8_LDB(B1, 0, 1); PG8_STAGE(PG8_SB(0, 0), b2, voffB);
            PG8_BAR; PG8_WAIT_L(0); PG8_MMA(0, 1, At, B1); PG8_BAR;
            PG8_LDA(At, 0, 1); PG8_STAGE(PG8_SA(0, 0), a2, voffA);
            PG8_BAR; PG8_WAIT_L(0); PG8_MMA(1, 0, At, B0); PG8_BAR; PG8_SCHED;
            PG8_STAGE(PG8_SB(0, 1), b2 + hstep, voffB);
            PG8_WAIT_V(6); PG8_BAR; PG8_MMA(1, 1, At, B1); PG8_BAR;
            PG8_LDB(B0, 1, 0); PG8_SCHED; PG8_LDA(At, 1, 0); PG8_STAGE(PG8_SA(0, 1), a2 + hstep, voffA);
            PG8_WAIT_L(8); PG8_BAR; PG8_WAIT_L(0); PG8_MMA(0, 0, At, B0); PG8_BAR; PG8_SCHED;
            PG8_LDB(B1, 1, 1); PG8_STAGE(PG8_SB(1, 0), b3, voffB);
            PG8_BAR; PG8_WAIT_L(0); PG8_MMA(0, 1, At, B1); PG8_BAR;
            PG8_LDA(At, 1, 1); PG8_STAGE(PG8_SA(1, 0), a3, voffA);
            PG8_BAR; PG8_WAIT_L(0); PG8_MMA(1, 0, At, B0); PG8_BAR; PG8_SCHED;
            PG8_STAGE(PG8_SB(1, 1), b3 + hstep, voffB);
            PG8_WAIT_V(6); PG8_BAR; PG8_MMA(1, 1, At, B1); PG8_BAR;
            }
        }
        if constexpr (ALIGN_EPI) { if (wr == 0) PG8_BAR; }
        if constexpr (!Epi::AFTER_DRAIN) { E(acc, cur, wr, wc, fr, fq); S.done(cur); }
        if (!has_next) break;
#pragma unroll
        for (int a = 0; a < 2; ++a)
#pragma unroll
            for (int b = 0; b < 2; ++b)
#pragma unroll
                for (int m = 0; m < 4; ++m)
#pragma unroll
                    for (int n = 0; n < 2; ++n) acc[a][b][m][n] = (f32x4){0.f, 0.f, 0.f, 0.f};
        cur = nxt; cA = nA; cB = nB; ++ui;
        if constexpr (ALIGN_EPI) { if (wr == 1) PG8_BAR; }
    }
    PG8_WAIT_V(0);
    if constexpr (!ALIGN_EPI) { if (wr == 0) PG8_BAR; }
    PG8_BAR;
    if constexpr (Epi::AFTER_DRAIN) { E.fused(acc, cur, wr, wc, fr, fq, lds, wid, lane); S.done(cur); }
#undef PG8_SA
#undef PG8_SB
#undef PG8_STAGE
#undef PG8_LDA
#undef PG8_LDB
#undef PG8_MMA
#undef PG8_WAIT_V
#undef PG8_WAIT_L
#undef PG8_BAR
#undef PG8_SCHED
}
}

constexpr int NWAVES = 8;
constexpr int BATCH = 8, SEQ = 8192, D = 1024, FF = 2816, INC = 3072, PW = 512, HW = 512, HD = 128;
constexpr int M = BATCH * SEQ;
constexpr float EPS = 1e-6f;
constexpr size_t MiB = 1u << 20;
constexpr size_t WS_SSQ = 0;
constexpr size_t WS_BAR = 1 * MiB + 512 * 1024;
constexpr size_t WS_OMLB = 1 * MiB;
constexpr size_t WS_WGU1 = 2 * MiB;
constexpr size_t WS_WD1 = 13 * MiB;
constexpr size_t WS_WIN = 19 * MiB;
constexpr size_t WS_WOUT = 25 * MiB;
constexpr size_t WS_WGU2 = 27 * MiB;
constexpr size_t WS_WD2 = 38 * MiB;
constexpr size_t WS_WPOOL = 44 * MiB;
constexpr size_t WS_ACTB = 48 * MiB;
constexpr size_t WS_YMIX = 176 * MiB;
constexpr size_t WS_PROJ = 304 * MiB;
constexpr size_t WS_LT = 688 * MiB;
constexpr size_t WS_POOLED = 944 * MiB;
constexpr size_t WS_END = 1008 * MiB;
constexpr int LDS_BYTES = 147456;

#define LAS __attribute__((address_space(3)))
typedef unsigned short bf16;
typedef unsigned v4u __attribute__((ext_vector_type(4)));
typedef unsigned v2u __attribute__((ext_vector_type(2)));
typedef float f32x4 __attribute__((ext_vector_type(4)));
typedef float f32x2 __attribute__((ext_vector_type(2)));
#define LDS_WAIT() asm volatile("s_waitcnt lgkmcnt(0)" ::: "memory")
__device__ __forceinline__ unsigned pk2(float lo, float hi) { return pg8::cvt_pk_bf16(lo, hi); }
__device__ __forceinline__ float bflo(unsigned w) { return __uint_as_float(w << 16); }
__device__ __forceinline__ float bfhi(unsigned w) { return __uint_as_float(w & 0xffff0000u); }
__device__ __forceinline__ float wave_sum(float v) {
#pragma unroll
    for (int o = 1; o < 64; o <<= 1) v += __shfl_xor(v, o);
    return v;
}

__device__ __forceinline__ void transpose_item(const float* W, int N, bf16* WT, int ldk, int koff, int mode, int rowoff, const float* ks, const float* ns, LAS float* scr, int item, int lane) {
    const int nblk = N / 32, kb = item / nblk, nb = item % nblk, k0 = 64 * kb, n0 = 32 * nb;
#pragma unroll
    for (int i = 0; i < 32; ++i) { const int kk = 2 * i + (lane >> 5); float w = __builtin_nontemporal_load(W + (size_t)(k0 + kk) * N + n0 + (lane & 31)); if (ks) w *= ks[k0 + kk]; scr[kk * 33 + (lane & 31)] = w; }
    LDS_WAIT(); asm volatile("" ::: "memory");
    const int c = lane & 7;
#pragma unroll
    for (int j = 0; j < 4; ++j) { const int n = (lane >> 3) + 8 * j; const LAS float* s = scr + (8 * c) * 33 + n; const float sc = ns ? ns[n0 + n] : 1.0f;
        v4u o; o.x = pk2(s[0 * 33] * sc, s[1 * 33] * sc); o.y = pk2(s[2 * 33] * sc, s[3 * 33] * sc); o.z = pk2(s[4 * 33] * sc, s[5 * 33] * sc); o.w = pk2(s[6 * 33] * sc, s[7 * 33] * sc);
        const int ng = n0 + n; const int drow = (mode == 1) ? (256 * (ng >> 7) + rowoff + (ng & 127)) : (rowoff + ng);
        *(v4u*)(WT + (size_t)drow * ldk + koff + k0 + 8 * c) = o; }
    LDS_WAIT(); asm volatile("" ::: "memory");
}

#define XB_TMO      128
#define XB_XCNT(j)  (256  + 64 * (j))
#define XB_XSUB(j)  (1280 + 64 * (j))
#define XB_XGEN(j)  (2304 + 64 * (j))
#define XB_TOP      3328
#define XB_TOPGEN   3392
#define XCD_BAR_WORDS 3456
#define XB_SPIN_CAP (1u << 18)

__device__ __forceinline__ unsigned xb_ld(unsigned* p)              { return __hip_atomic_load(p, __ATOMIC_RELAXED, __HIP_MEMORY_SCOPE_AGENT); }
__device__ __forceinline__ unsigned xb_add(unsigned* p, unsigned v) { return __hip_atomic_fetch_add(p, v, __ATOMIC_RELAXED, __HIP_MEMORY_SCOPE_AGENT); }
__device__ __forceinline__ unsigned xb_xcc_id() { return (unsigned)__builtin_amdgcn_s_getreg((3 << 11) | 20) & 0xFu; }
#define XB_SPIN(cond, bar) do { unsigned _sp = 0; while (cond) { __builtin_amdgcn_s_sleep(1); \
    if ((++_sp & 255u) == 0u) { if (xb_ld(&(bar)[XB_TMO])) break; if (_sp > XB_SPIN_CAP) { atomicAdd(&(bar)[XB_TMO], 1u); break; } } } } while (0)

struct XcdBarrier {
    unsigned* bar; unsigned x;
    volatile LAS unsigned* st;
};

__device__ __forceinline__ XcdBarrier xcd_barrier_post(unsigned* bar, volatile LAS unsigned* st) {
    XcdBarrier b; b.bar = bar; b.x = xb_xcc_id(); b.st = st;
    if (threadIdx.x == 0) (void)xb_add(&bar[XB_XCNT(b.x)], 1u);
    return b;
}
__device__ __forceinline__ void xcd_barrier_complete(unsigned* bar, unsigned x, unsigned& nloc, unsigned& nx) {
    const unsigned G = gridDim.x * gridDim.y * gridDim.z;
    unsigned sum, cnt, mine, sp = 0u;
    for (;;) {
        sum = 0u; cnt = 0u; mine = 0u;
#pragma unroll
        for (unsigned j = 0; j < 16; ++j) { const unsigned c = xb_ld(&bar[XB_XCNT(j)]); sum += c; cnt += (c > 0u) ? 1u : 0u; mine = (j == x) ? c : mine; }
        if (sum == G) break;
        __builtin_amdgcn_s_sleep(1);
        if ((++sp & 255u) == 0u) { if (xb_ld(&bar[XB_TMO])) break; if (sp > XB_SPIN_CAP) { atomicAdd(&bar[XB_TMO], 1u); break; } }
    }
    nloc = mine > 0u ? mine : 1u; nx = cnt > 0u ? cnt : 1u;
}

__device__ __forceinline__ void xcd_barrier(const XcdBarrier& b) {
    asm volatile("s_waitcnt vmcnt(0)" ::: "memory");
    __syncthreads();
    if (threadIdx.x == 0) {
        unsigned* bar = b.bar;
        __builtin_amdgcn_s_waitcnt(0);
        unsigned nloc = b.st[0], nx = b.st[1];
        if (nloc == 0u) { xcd_barrier_complete(bar, b.x, nloc, nx); b.st[0] = nloc; b.st[1] = nx; }
        const unsigned old = xb_add(&bar[XB_XSUB(b.x)], 1u);
        const unsigned gen = old / nloc;
        if (old + 1u == (gen + 1u) * nloc) {
            __builtin_amdgcn_fence(__ATOMIC_RELEASE, "agent");
            asm volatile("s_waitcnt vmcnt(0)" ::: "memory");
            const unsigned og = xb_add(&bar[XB_TOP], 1u);
            const unsigned tg = og / nx;
            if (og + 1u == (tg + 1u) * nx) xb_add(&bar[XB_TOPGEN], 1u);
            else XB_SPIN(xb_ld(&bar[XB_TOPGEN]) == tg, bar);
            __builtin_amdgcn_fence(__ATOMIC_ACQUIRE, "agent");
            xb_add(&bar[XB_XGEN(b.x)], 1u);
            asm volatile("s_waitcnt vmcnt(0)" ::: "memory");
        } else {
            XB_SPIN(xb_ld(&bar[XB_XGEN(b.x)]) == gen, bar);
            __builtin_amdgcn_fence(__ATOMIC_ACQUIRE, "agent");
            asm volatile("s_waitcnt vmcnt(0)" ::: "memory");
        }
    }
    __syncthreads();
}

struct Args { const float* in[17]; float* out; unsigned char* ws; };

__device__ __forceinline__ void p0_prologue(const Args& a, LAS unsigned char* lds, int gw, int NGW, int wave, int lane) {
    unsigned char* ws = a.ws;
    LAS float* scr = (LAS float*)(lds + wave * 16384);
    constexpr int I_GU = (D / 64) * (FF / 32), I_DN = (FF / 64) * (D / 32), I_IN = (D / 64) * (INC / 32), I_OUT = (HW / 64) * (D / 32);
    constexpr int NITEMS = 4 * I_GU + 2 * I_DN + I_IN + I_OUT;
    for (int it = gw; it < NITEMS; it += NGW) {
        int r = it;
        if (r < I_GU) { transpose_item(a.in[2], FF, (bf16*)(ws + WS_WGU1), D, 0, 1, 0, a.in[1], nullptr, scr, r, lane); continue; } r -= I_GU;
        if (r < I_GU) { transpose_item(a.in[3], FF, (bf16*)(ws + WS_WGU1), D, 0, 1, 128, a.in[1], nullptr, scr, r, lane); continue; } r -= I_GU;
        if (r < I_GU) { transpose_item(a.in[13], FF, (bf16*)(ws + WS_WGU2), D, 0, 1, 0, a.in[12], nullptr, scr, r, lane); continue; } r -= I_GU;
        if (r < I_GU) { transpose_item(a.in[14], FF, (bf16*)(ws + WS_WGU2), D, 0, 1, 128, a.in[12], nullptr, scr, r, lane); continue; } r -= I_GU;
        if (r < I_DN) { transpose_item(a.in[4], D, (bf16*)(ws + WS_WD1), FF, 0, 0, 0, nullptr, nullptr, scr, r, lane); continue; } r -= I_DN;
        if (r < I_DN) { transpose_item(a.in[15], D, (bf16*)(ws + WS_WD2), FF, 0, 0, 0, nullptr, nullptr, scr, r, lane); continue; } r -= I_DN;
        if (r < I_IN) { transpose_item(a.in[6], INC, (bf16*)(ws + WS_WIN), D, 0, 0, 0, a.in[5], nullptr, scr, r, lane); continue; } r -= I_IN;
        transpose_item(a.in[11], D, (bf16*)(ws + WS_WOUT), D, 0, 0, 0, nullptr, nullptr, scr, r + (PW / 64) * (D / 32), lane);
    }
    for (int wi = gw; wi < 2048; wi += NGW) {
        const int n = (wi & 15) * 64 + lane, kq = wi >> 4, g = kq >> 5, c0 = (kq & 31) * 4;
        const float* wo = a.in[11] + (size_t)(g * 128) * D + n; const float* pw = a.in[7] + (size_t)(g * 128 + c0) * 128; const float* ps = a.in[8] + g * 128;
        f32x4 acc4 = (f32x4){0.f, 0.f, 0.f, 0.f};
#pragma unroll 8
        for (int d = 0; d < 128; d += 4) {
            const f32x4 p4 = *(const f32x4*)(ps + d);
            const f32x4 w4 = (f32x4){wo[(size_t)d * D], wo[(size_t)(d + 1) * D], wo[(size_t)(d + 2) * D], wo[(size_t)(d + 3) * D]} * p4;
#pragma unroll
            for (int e = 0; e < 4; ++e) { const f32x4 q4 = *(const f32x4*)(pw + e * 128 + d); acc4[e] += (w4[0] * q4[0] + w4[1] * q4[1]) + (w4[2] * q4[2] + w4[3] * q4[3]); } }
        *(v2u*)((bf16*)(ws + WS_WOUT) + (size_t)n * D + kq * 4) = (v2u){pk2(acc4[0], acc4[1]), pk2(acc4[2], acc4[3])};
    }
    const float* x = a.in[0]; bf16* xb = (bf16*)(ws + WS_ACTB); float* ssq = (float*)(ws + WS_SSQ);
    for (int m = gw; m < M; m += NGW) {
        const f32x4* xr = (const f32x4*)(x + (size_t)m * D) + lane; f32x4 v[4]; float s = 0.f;
#pragma unroll
        for (int j = 0; j < 4; ++j) { v[j] = __builtin_nontemporal_load(xr + 64 * j); s += (v[j].x * v[j].x + v[j].y * v[j].y) + (v[j].z * v[j].z + v[j].w * v[j].w); }
        s = wave_sum(s);
        v2u* o8 = (v2u*)(xb + (size_t)m * D) + lane;
#pragma unroll
        for (int j = 0; j < 4; ++j) o8[64 * j] = (v2u){pk2(v[j].x, v[j].y), pk2(v[j].z, v[j].w)};
        if (lane == 0) { ssq[m] = s; ssq[M + m] = 0.f; ssq[2 * M + m] = 0.f; ssq[3 * M + m] = 0.f; }
    }
    if (gw < 16) { const int i = gw * 64 + lane; const int d = i >> 9, w = i & 511; const float a0 = a.in[9][d * 1024 + w], a1 = a.in[9][d * 1024 + 512 + w];
        ((float*)(ws + WS_OMLB))[i] = 1.0f / (1.0f + expf(a0 - a1)); }
}

__device__ __forceinline__ void pool_rows(const bf16* proj, bf16* pooled, int gw, int NGW, int lane) {
    const int g = lane >> 4, half = 1 << g;
    float mul[16];
#pragma unroll
    for (int d = 0; d < 16; ++d) mul[d] = (d - 8 >= -half && d - 8 < half) ? 1.0f : 0.0f;
    for (int blk = gw; blk < M / 8; blk += NGW) {
        const int m0 = blk * 8, t0 = m0 & (SEQ - 1);
        const bf16* base = proj + (size_t)(m0 - t0) * INC + lane * 8;
        v4u z[24];
#pragma unroll
        for (int j = 0; j < 24; ++j) { const int t = t0 - 8 + j; z[j] = (t >= 0 && t < SEQ) ? __builtin_nontemporal_load((const v4u*)(base + (size_t)t * INC)) : (v4u){0u, 0u, 0u, 0u}; }
#pragma unroll
        for (int r = 0; r < 8; ++r) {
            float s[8];
#pragma unroll
            for (int e = 0; e < 8; ++e) s[e] = 0.f;
#pragma unroll
            for (int d = 0; d < 16; ++d) { const v4u w = z[r + d]; const float ml = mul[d];
                s[0] += ml * bflo(w.x); s[1] += ml * bfhi(w.x); s[2] += ml * bflo(w.y); s[3] += ml * bfhi(w.y); s[4] += ml * bflo(w.z); s[5] += ml * bfhi(w.z); s[6] += ml * bflo(w.w); s[7] += ml * bfhi(w.w); }
            const int t = t0 + r; const int lo = (t - half) < 0 ? 0 : (t - half), hi = (t + half) > SEQ ? SEQ : (t + half);
            const float inv = 1.0f / (float)(hi - lo); const v4u zc = z[r + 8];
            v4u o; o.x = pk2(s[0] * inv - bflo(zc.x), s[1] * inv - bfhi(zc.x)); o.y = pk2(s[2] * inv - bflo(zc.y), s[3] * inv - bfhi(zc.y));
            o.z = pk2(s[4] * inv - bflo(zc.z), s[5] * inv - bfhi(zc.z)); o.w = pk2(s[6] * inv - bflo(zc.w), s[7] * inv - bfhi(zc.w));
            __builtin_nontemporal_store(o, (v4u*)(pooled + (size_t)(m0 + r) * D + lane * 8));
        }
    }
}

typedef short bf16x8 __attribute__((ext_vector_type(8)));
__device__ __forceinline__ f32x4 mfma16(bf16x8 x, bf16x8 y, f32x4 c) { return __builtin_amdgcn_mfma_f32_16x16x32_bf16(x, y, c, 0, 0, 0); }
constexpr int TR_STRIDE = 144;
constexpr int CH_STRIDE = 272;

__device__ __forceinline__ float fast_ln(float x) { return __builtin_amdgcn_logf(x) * 0.69314718f; }
constexpr float ST_SCALE = 8.0f, ST_INV = 1.0f / 8.0f, ST_MAX = 440.0f;
__device__ __forceinline__ float st_clamp(float x) { return fminf(fmaxf(x, -ST_MAX), ST_MAX); }
__device__ __forceinline__ unsigned pack_fp8x4(float a, float b, float c, float d) {
    int w = 0; w = __builtin_amdgcn_cvt_pk_fp8_f32(st_clamp(a), st_clamp(b), w, false); w = __builtin_amdgcn_cvt_pk_fp8_f32(st_clamp(c), st_clamp(d), w, true); return (unsigned)w; }
__device__ __forceinline__ f32x4 unpack_fp8x4(unsigned w) { const f32x2 lo = __builtin_amdgcn_cvt_pk_f32_fp8((int)w, false), hi = __builtin_amdgcn_cvt_pk_f32_fp8((int)w, true); return (f32x4){lo.x, lo.y, hi.x, hi.y}; }

__device__ __forceinline__ void hgrn_local_item(const bf16* proj, bf16* LT, float* DV, LAS unsigned char* lds, int it, int tid) {
    const int b = it >> 9, head = (it >> 7) & 3, c = it & 127;
    const int cp = tid & 63, pg = __builtin_amdgcn_readfirstlane(tid >> 6), lane = tid & 63, fr = lane & 15, fq = lane >> 4;
    LAS unsigned char* VT = lds;
    LAS unsigned char* KF = lds + 128 * TR_STRIDE;
    LAS unsigned char* KB = lds + 2 * 128 * TR_STRIDE;
    LAS float* TF = (LAS float*)(lds + 3 * 128 * TR_STRIDE);
    LAS float* TB = TF + 1024;
    const size_t row0 = (size_t)b * SEQ + c * 64 + pg * 8;
    const bf16* pv = proj + row0 * INC + 1024 + head * 128 + 2 * cp;
    const bf16* pkf = proj + row0 * INC + 1536 + head * 128 + 2 * cp;
    const bf16* pkb = pkf + 512;
    unsigned rv[8], rkf[8], rkb[8];
#pragma unroll
    for (int i = 0; i < 8; ++i) { rv[i] = __builtin_nontemporal_load((const unsigned*)(pv + (size_t)i * INC)); rkf[i] = __builtin_nontemporal_load((const unsigned*)(pkf + (size_t)i * INC)); rkb[i] = __builtin_nontemporal_load((const unsigned*)(pkb + (size_t)i * INC)); }
    float gf[8][2], gb[8][2]; float tf0 = 0.f, tf1 = 0.f, tb0 = 0.f, tb1 = 0.f;
#pragma unroll
    for (int i = 0; i < 8; ++i) { gf[i][0] = fast_ln(1.0f - bflo(rkf[i])); gf[i][1] = fast_ln(1.0f - bfhi(rkf[i])); gb[i][0] = fast_ln(1.0f - bflo(rkb[i])); gb[i][1] = fast_ln(1.0f - bfhi(rkb[i]));
        tf0 += gf[i][0]; tf1 += gf[i][1]; tb0 += gb[i][0]; tb1 += gb[i][1]; }
    *(LAS f32x2*)(TF + pg * 128 + 2 * cp) = (f32x2){tf0, tf1}; *(LAS f32x2*)(TB + pg * 128 + 2 * cp) = (f32x2){tb0, tb1};
    { v4u w0, w1;
      w0.x = (rv[0] & 0xffffu) | (rv[1] << 16); w0.y = (rv[2] & 0xffffu) | (rv[3] << 16); w0.z = (rv[4] & 0xffffu) | (rv[5] << 16); w0.w = (rv[6] & 0xffffu) | (rv[7] << 16);
      w1.x = (rv[0] >> 16) | (rv[1] & 0xffff0000u); w1.y = (rv[2] >> 16) | (rv[3] & 0xffff0000u); w1.z = (rv[4] >> 16) | (rv[5] & 0xffff0000u); w1.w = (rv[6] >> 16) | (rv[7] & 0xffff0000u);
      *(LAS v4u*)(VT + (2 * cp) * TR_STRIDE + pg * 16) = w0; *(LAS v4u*)(VT + (2 * cp + 1) * TR_STRIDE + pg * 16) = w1; }
    __syncthreads();
    float af0 = 0.f, af1 = 0.f, bb0 = 0.f, bb1 = 0.f, sf0 = 0.f, sf1 = 0.f, sb0 = 0.f, sb1 = 0.f;
#pragma unroll
    for (int p = 0; p < 8; ++p) { const f32x2 a = *(const LAS f32x2*)(TF + p * 128 + 2 * cp), bq = *(const LAS f32x2*)(TB + p * 128 + 2 * cp);
        sf0 += a.x; sf1 += a.y; sb0 += bq.x; sb1 += bq.y; if (p > pg) { af0 += a.x; af1 += a.y; } if (p < pg) { bb0 += bq.x; bb1 += bq.y; } }
    const int seqf = (b * 4 + head) * 128 + c, seqb = ((32 + b * 4 + head)) * 128 + c;
    if (pg == 0) { *(f32x2*)(DV + (size_t)seqf * 128 + 2 * cp) = (f32x2){__expf(sf0), __expf(sf1)}; *(f32x2*)(DV + (size_t)seqb * 128 + 2 * cp) = (f32x2){__expf(sb0), __expf(sb1)}; }
    { float kd[8][2];
#pragma unroll
      for (int i = 7; i >= 0; --i) { kd[i][0] = bflo(rkf[i]) * __expf(af0); kd[i][1] = bfhi(rkf[i]) * __expf(af1); af0 += gf[i][0]; af1 += gf[i][1]; }
      v4u w0, w1; w0.x = pk2(kd[0][0], kd[1][0]); w0.y = pk2(kd[2][0], kd[3][0]); w0.z = pk2(kd[4][0], kd[5][0]); w0.w = pk2(kd[6][0], kd[7][0]);
      w1.x = pk2(kd[0][1], kd[1][1]); w1.y = pk2(kd[2][1], kd[3][1]); w1.z = pk2(kd[4][1], kd[5][1]); w1.w = pk2(kd[6][1], kd[7][1]);
      *(LAS v4u*)(KF + (2 * cp) * TR_STRIDE + pg * 16) = w0; *(LAS v4u*)(KF + (2 * cp + 1) * TR_STRIDE + pg * 16) = w1;
#pragma unroll
      for (int i = 0; i < 8; ++i) { kd[i][0] = bflo(rkb[i]) * __expf(bb0); kd[i][1] = bfhi(rkb[i]) * __expf(bb1); bb0 += gb[i][0]; bb1 += gb[i][1]; }
      w0.x = pk2(kd[0][0], kd[1][0]); w0.y = pk2(kd[2][0], kd[3][0]); w0.z = pk2(kd[4][0], kd[5][0]); w0.w = pk2(kd[6][0], kd[7][0]);
      w1.x = pk2(kd[0][1], kd[1][1]); w1.y = pk2(kd[2][1], kd[3][1]); w1.z = pk2(kd[4][1], kd[5][1]); w1.w = pk2(kd[6][1], kd[7][1]);
      *(LAS v4u*)(KB + (2 * cp) * TR_STRIDE + pg * 16) = w0; *(LAS v4u*)(KB + (2 * cp + 1) * TR_STRIDE + pg * 16) = w1; }
    __syncthreads();
    { const int dir = pg >> 2, tv0 = 2 * (pg & 3); const LAS unsigned char* KD = dir ? KB : KF;
      unsigned char* out = (unsigned char*)LT + (size_t)(dir ? seqb : seqf) * 16384;
      bf16x8 y0[2], y1[2];
#pragma unroll
      for (int ks = 0; ks < 2; ++ks) { y0[ks] = *(const LAS bf16x8*)(VT + (16 * tv0 + fr) * TR_STRIDE + (32 * ks + 8 * fq) * 2); y1[ks] = *(const LAS bf16x8*)(VT + (16 * tv0 + 16 + fr) * TR_STRIDE + (32 * ks + 8 * fq) * 2); }
#pragma unroll
      for (int tk = 0; tk < 8; ++tk) { f32x4 a0 = (f32x4){0.f, 0.f, 0.f, 0.f}, a1 = a0;
#pragma unroll
          for (int ks = 0; ks < 2; ++ks) { const bf16x8 x = *(const LAS bf16x8*)(KD + (16 * tk + fr) * TR_STRIDE + (32 * ks + 8 * fq) * 2); a0 = mfma16(x, y0[ks], a0); a1 = mfma16(x, y1[ks], a1); }
          *(unsigned*)(out + (size_t)(16 * tv0 + fr) * 128 + 16 * tk + 4 * fq) = pack_fp8x4(a0[0] * ST_SCALE, a0[1] * ST_SCALE, a0[2] * ST_SCALE, a0[3] * ST_SCALE);
          *(unsigned*)(out + (size_t)(16 * tv0 + 16 + fr) * 128 + 16 * tk + 4 * fq) = pack_fp8x4(a1[0] * ST_SCALE, a1[1] * ST_SCALE, a1[2] * ST_SCALE, a1[3] * ST_SCALE); } }
    __syncthreads();
}

__device__ __forceinline__ void hgrn_state_scan(bf16* LT, const float* DV, int T, int NT) {
    for (int x = T; x < 64 * 2048; x += NT) {
        const int seqi = x >> 11, e8 = x & 2047, dir = seqi >> 5, k0 = (e8 & 15) * 8;
        unsigned char* base = (unsigned char*)LT + (size_t)seqi * 128 * 16384 + e8 * 8; const float* dbase = DV + (size_t)seqi * 128 * 128 + k0;
        f32x4 S0 = (f32x4){0.f, 0.f, 0.f, 0.f}, S1 = S0;
        for (int cc = 0; cc < 128; cc += 8) {
            v2u L[8]; f32x4 d0[8], d1[8];
#pragma unroll
            for (int j = 0; j < 8; ++j) { const int c = dir ? (127 - cc - j) : (cc + j); L[j] = __builtin_nontemporal_load((const v2u*)(base + (size_t)c * 16384)); d0[j] = *(const f32x4*)(dbase + c * 128); d1[j] = *(const f32x4*)(dbase + c * 128 + 4); }
#pragma unroll
            for (int j = 0; j < 8; ++j) { const int c = dir ? (127 - cc - j) : (cc + j);
                *(v2u*)(base + (size_t)c * 16384) = (v2u){pack_fp8x4(S0[0], S0[1], S0[2], S0[3]), pack_fp8x4(S1[0], S1[1], S1[2], S1[3])};
                S0 = d0[j] * S0 + unpack_fp8x4(L[j].x); S1 = d1[j] * S1 + unpack_fp8x4(L[j].y); }
        }
    }
}

__device__ __forceinline__ bf16x8 frag_fp8(const LAS unsigned char* p) {
    const v2u w = *(const LAS v2u*)p; const f32x4 a = unpack_fp8x4(w.x), c = unpack_fp8x4(w.y);
    return __builtin_bit_cast(bf16x8, (v4u){pk2(a[0], a[1]), pk2(a[2], a[3]), pk2(c[0], c[1]), pk2(c[2], c[3])});
}
struct HoP { unsigned rq[8], rv[8], rkf[8], rkb[8]; };
__device__ __forceinline__ void hgrn_out_loadp(const bf16* proj, int it, int tid, HoP& P) {
    const int b = it >> 9, head = (it >> 7) & 3, c = it & 127, cp = tid & 63, pg = __builtin_amdgcn_readfirstlane(tid >> 6);
    const bf16* pq = proj + ((size_t)b * SEQ + c * 64 + pg * 8) * INC + 512 + head * 128 + 2 * cp;
#pragma unroll
    for (int i = 0; i < 8; ++i) { P.rq[i] = __builtin_nontemporal_load((const unsigned*)(pq + (size_t)i * INC)); P.rv[i] = __builtin_nontemporal_load((const unsigned*)(pq + (size_t)i * INC + 512));
        P.rkf[i] = __builtin_nontemporal_load((const unsigned*)(pq + (size_t)i * INC + 1024)); P.rkb[i] = __builtin_nontemporal_load((const unsigned*)(pq + (size_t)i * INC + 1536)); }
}
__device__ __forceinline__ void hgrn_out_item(const bf16* proj, const bf16* LT, const float* gnorm, bf16* ymix, LAS unsigned char* lds, int it, int tid, const HoP& R, int it_next, HoP& NX) {
    const int b = it >> 9, head = (it >> 7) & 3, c = it & 127;
    const int cp = tid & 63, pg = __builtin_amdgcn_readfirstlane(tid >> 6), lane = tid & 63, fr = lane & 15, fq = lane >> 4;
    LAS unsigned char* QTB = lds;
    LAS unsigned char* KTB = lds + 64 * CH_STRIDE;
    LAS unsigned char* VT = lds + 256 * CH_STRIDE;
    LAS unsigned char* PP = VT + 128 * TR_STRIDE;
    LAS unsigned char* S8 = PP + 64 * TR_STRIDE;
    LAS float* TF = (LAS float*)(S8 + 2 * 128 * TR_STRIDE);
    LAS float* TB = TF + 1024;
    LAS float* RS = TB + 1024;
    const int ti = pg & 3, hv = pg >> 2;
    v4u rawS[2][2];
#pragma unroll
    for (int dd = 0; dd < 2; ++dd) { const unsigned char* Sg = (const unsigned char*)LT + ((size_t)((dd * 32 + b * 4 + head) * 128 + c)) * 16384;
#pragma unroll
        for (int i = 0; i < 2; ++i) rawS[dd][i] = __builtin_nontemporal_load((const v4u*)(Sg + (size_t)(tid + 512 * i) * 16)); }
    v2u gzr[4];
    { const size_t rowg = (size_t)b * SEQ + c * 64 + 16 * ti + fr;
#pragma unroll
      for (int t = 0; t < 4; ++t) gzr[t] = __builtin_nontemporal_load((const v2u*)(proj + rowg * INC + 2560 + head * 128 + 64 * hv + 16 * t + 4 * fq)); }
    { float tf0 = 0.f, tf1 = 0.f, tb0 = 0.f, tb1 = 0.f;
#pragma unroll
      for (int i = 0; i < 8; ++i) { tf0 += fast_ln(1.0f - bflo(R.rkf[i])); tf1 += fast_ln(1.0f - bfhi(R.rkf[i])); tb0 += fast_ln(1.0f - bflo(R.rkb[i])); tb1 += fast_ln(1.0f - bfhi(R.rkb[i])); }
      *(LAS f32x2*)(TF + pg * 128 + 2 * cp) = (f32x2){tf0, tf1}; *(LAS f32x2*)(TB + pg * 128 + 2 * cp) = (f32x2){tb0, tb1};
      v4u w0, w1;
      w0.x = (R.rv[0] & 0xffffu) | (R.rv[1] << 16); w0.y = (R.rv[2] & 0xffffu) | (R.rv[3] << 16); w0.z = (R.rv[4] & 0xffffu) | (R.rv[5] << 16); w0.w = (R.rv[6] & 0xffffu) | (R.rv[7] << 16);
      w1.x = (R.rv[0] >> 16) | (R.rv[1] & 0xffff0000u); w1.y = (R.rv[2] >> 16) | (R.rv[3] & 0xffff0000u); w1.z = (R.rv[4] >> 16) | (R.rv[5] & 0xffff0000u); w1.w = (R.rv[6] >> 16) | (R.rv[7] & 0xffff0000u);
      *(LAS v4u*)(VT + (2 * cp) * TR_STRIDE + pg * 16) = w0; *(LAS v4u*)(VT + (2 * cp + 1) * TR_STRIDE + pg * 16) = w1; }
    __syncthreads();
    if (it_next < 4096) hgrn_out_loadp(proj, it_next, tid, NX);
#pragma unroll
    for (int dir = 0; dir < 2; ++dir) {
        const LAS float* TT = dir ? TB : TF; float o0 = 0.f, o1 = 0.f;
        LAS unsigned char* QT = QTB + dir * 128 * CH_STRIDE; LAS unsigned char* KT = KTB + dir * 128 * CH_STRIDE;
#pragma unroll
        for (int p = 0; p < 8; ++p) { const f32x2 a = *(const LAS f32x2*)(TT + p * 128 + 2 * cp); if (dir ? (p > pg) : (p < pg)) { o0 += a.x; o1 += a.y; } }
#pragma unroll
        for (int ii = 0; ii < 8; ++ii) { const int i = dir ? (7 - ii) : ii; const unsigned rk = dir ? R.rkb[i] : R.rkf[i];
            const float k0 = bflo(rk), k1 = bfhi(rk); o0 += fast_ln(1.0f - k0); o1 += fast_ln(1.0f - k1);
            const float e0 = __expf(o0), e1 = __expf(o1), n0 = __expf(-o0), n1 = __expf(-o1);
            *(LAS unsigned*)(QT + (8 * pg + i) * CH_STRIDE + 4 * cp) = pk2(bflo(R.rq[i]) * e0, bfhi(R.rq[i]) * e1);
            *(LAS unsigned*)(KT + (8 * pg + i) * CH_STRIDE + 4 * cp) = pk2(k0 * n0, k1 * n1); }
    }
#pragma unroll
    for (int dd = 0; dd < 2; ++dd)
#pragma unroll
        for (int i = 0; i < 2; ++i) { const int e = tid + 512 * i; *(LAS v4u*)(S8 + dd * 128 * TR_STRIDE + (e >> 3) * TR_STRIDE + (e & 7) * 16) = rawS[dd][i]; }
    __syncthreads();
    bf16x8 yq[2][4];
#pragma unroll
    for (int dir = 0; dir < 2; ++dir)
#pragma unroll
        for (int ks = 0; ks < 4; ++ks) yq[dir][ks] = *(const LAS bf16x8*)(QTB + dir * 128 * CH_STRIDE + (16 * ti + fr) * CH_STRIDE + (32 * ks + 8 * fq) * 2);
#pragma unroll
    for (int jj = 0; jj < 2; ++jj) { const int tj = 2 * hv + jj; f32x4 st = (f32x4){0.f, 0.f, 0.f, 0.f};
        const int ipos = 16 * ti + fr, j0 = 16 * tj + 4 * fq;
#pragma unroll
        for (int dir = 0; dir < 2; ++dir) {
            if (dir ? (tj >= ti) : (tj <= ti)) { f32x4 sd = (f32x4){0.f, 0.f, 0.f, 0.f};
#pragma unroll
                for (int ks = 0; ks < 4; ++ks) { const bf16x8 x = *(const LAS bf16x8*)(KTB + dir * 128 * CH_STRIDE + (16 * tj + fr) * CH_STRIDE + (32 * ks + 8 * fq) * 2); sd = mfma16(x, yq[dir][ks], sd); }
#pragma unroll
                for (int e = 0; e < 4; ++e) { const bool keep = dir ? (j0 + e >= ipos) : (j0 + e <= ipos); st[e] += keep ? sd[e] : 0.f; } } }
        *(LAS v2u*)(PP + (16 * ti + fr) * TR_STRIDE + (16 * tj + 4 * fq) * 2) = (v2u){pk2(st[0], st[1]), pk2(st[2], st[3])}; }
    __syncthreads();
    f32x4 acc[4], acci[4];
    { bf16x8 yp[2];
#pragma unroll
      for (int ks = 0; ks < 2; ++ks) yp[ks] = *(const LAS bf16x8*)(PP + (16 * ti + fr) * TR_STRIDE + (32 * ks + 8 * fq) * 2);
#pragma unroll
      for (int t = 0; t < 4; ++t) { const int tv = 4 * hv + t; acc[t] = (f32x4){0.f, 0.f, 0.f, 0.f}; acci[t] = acc[t];
#pragma unroll
          for (int ks = 0; ks < 2; ++ks) { const bf16x8 x = *(const LAS bf16x8*)(VT + (16 * tv + fr) * TR_STRIDE + (32 * ks + 8 * fq) * 2); acc[t] = mfma16(x, yp[ks], acc[t]); }
#pragma unroll
          for (int dir = 0; dir < 2; ++dir)
#pragma unroll
              for (int ks = 0; ks < 4; ++ks) { const bf16x8 x = frag_fp8(S8 + dir * 128 * TR_STRIDE + (16 * tv + fr) * TR_STRIDE + 32 * ks + 8 * fq); acci[t] = mfma16(x, yq[dir][ks], acci[t]); }
          acc[t] = acc[t] + acci[t] * ST_INV; } }
    float ss = 0.f;
#pragma unroll
    for (int t = 0; t < 4; ++t) ss += (acc[t][0] * acc[t][0] + acc[t][1] * acc[t][1]) + (acc[t][2] * acc[t][2] + acc[t][3] * acc[t][3]);
    ss += __shfl_xor(ss, 16); ss += __shfl_xor(ss, 32);
    if (fq == 0) RS[hv * 64 + 16 * ti + fr] = ss;
    __syncthreads();
    const float r = __builtin_amdgcn_rsqf((RS[16 * ti + fr] + RS[64 + 16 * ti + fr]) * (1.0f / 128.0f) + EPS);
    const size_t row = (size_t)b * SEQ + c * 64 + 16 * ti + fr;
#pragma unroll
    for (int t = 0; t < 4; ++t) { const int vcol = 64 * hv + 16 * t + 4 * fq; const f32x4 gn = *(const f32x4*)(gnorm + vcol);
        const v2u gz = gzr[t];
        *(v2u*)(ymix + row * D + 512 + head * 128 + vcol) = (v2u){pk2(acc[t][0] * r * gn[0] * bflo(gz.x), acc[t][1] * r * gn[1] * bfhi(gz.x)), pk2(acc[t][2] * r * gn[2] * bflo(gz.y), acc[t][3] * r * gn[3] * bfhi(gz.y))}; }
}

__device__ __forceinline__ void final_norm(const bf16* hb, float* out, const float* ssq3, const float* wf, int gw, int NGW, int lane) {
    f32x4 w4[4];
#pragma unroll
    for (int j = 0; j < 2; ++j) { w4[2 * j] = *(const f32x4*)(wf + 512 * j + lane * 8); w4[2 * j + 1] = *(const f32x4*)(wf + 512 * j + lane * 8 + 4); }
    for (int m = gw; m < M; m += NGW) {
        const float r = __builtin_amdgcn_rsqf(ssq3[m] * (1.0f / 1024.0f) + EPS);
        const v4u h0 = __builtin_nontemporal_load((const v4u*)(hb + (size_t)m * D + lane * 8)), h1 = __builtin_nontemporal_load((const v4u*)(hb + (size_t)m * D + 512 + lane * 8));
        float* o = out + (size_t)m * D + lane * 8;
        __builtin_nontemporal_store((f32x4){bflo(h0.x), bfhi(h0.x), bflo(h0.y), bfhi(h0.y)} * r * w4[0], (f32x4*)(o));
        __builtin_nontemporal_store((f32x4){bflo(h0.z), bfhi(h0.z), bflo(h0.w), bfhi(h0.w)} * r * w4[1], (f32x4*)(o + 4));
        __builtin_nontemporal_store((f32x4){bflo(h1.x), bfhi(h1.x), bflo(h1.y), bfhi(h1.y)} * r * w4[2], (f32x4*)(o + 512));
        __builtin_nontemporal_store((f32x4){bflo(h1.z), bfhi(h1.z), bflo(h1.w), bfhi(h1.w)} * r * w4[3], (f32x4*)(o + 516));
    }
}

__global__ void __launch_bounds__(NWAVES * 64, 2) mk_fwd(Args args) {
    extern __shared__ __attribute__((aligned(16))) unsigned char lds_raw[];
    cg::grid_group grid = cg::this_grid();
    LAS unsigned char* lds = (LAS unsigned char*)lds_raw;
    const int tid = threadIdx.x, lane = tid & 63, wave = __builtin_amdgcn_readfirstlane(tid >> 6);
    const int G = gridDim.x, bx = blockIdx.x;
    const int vcu = (G % 8 == 0) ? (bx % 8) * (G / 8) + bx / 8 : bx;
    const int gw = vcu * NWAVES + wave, NGW = G * NWAVES;
    unsigned char* ws = args.ws;
    float* ssq = (float*)(ws + WS_SSQ);
    bf16* actb = (bf16*)(ws + WS_ACTB); bf16* ymix = (bf16*)(ws + WS_YMIX); bf16* proj = (bf16*)(ws + WS_PROJ); bf16* hid = (bf16*)(ws + WS_PROJ);
    bf16* LT = (bf16*)(ws + WS_LT); float* DV = args.out; bf16* pooled = (bf16*)(ws + WS_POOLED);

    volatile LAS unsigned* MISC = (volatile LAS unsigned*)(lds + 143360);
    if (tid < 32) MISC[tid] = 0u;
    __syncthreads();
    const XcdBarrier bar = xcd_barrier_post((unsigned*)(ws + WS_BAR), MISC + 8);
    p0_prologue(args, lds, gw, NGW, wave, lane);
    if (args.ws == nullptr) grid.sync();
    xcd_barrier(bar);
    { pg8::Gemm g{actb, (const bf16*)(ws + WS_WGU1), M, 2 * FF, D}; pg8::StaticOrder S; S.init(M, 2 * FF, G, bx);
      pg8::EpiSwiglu E{hid, FF, ssq};
      pg8::gemm_phase<pg8::EpiSwiglu, pg8::StaticOrder, true, true>(lds, g, S, E); }
    xcd_barrier(bar);
    { pg8::Gemm g{hid, (const bf16*)(ws + WS_WD1), M, D, FF}; pg8::StaticOrder S; S.init(M, D, G, bx, 1);
      pg8::EpiResid E{actb, ssq + M, 0.5f, D};
      pg8::gemm_phase<pg8::EpiResid, pg8::StaticOrder, true, true>(lds, g, S, E); }
    xcd_barrier(bar);
    { pg8::Gemm g{actb, (const bf16*)(ws + WS_WIN), M, INC, D}; pg8::StaticOrder S; S.init(M, INC, G, bx);
      pg8::EpiProj E{proj, INC, ssq + M, (const float*)(ws + WS_OMLB)};
      pg8::gemm_phase<pg8::EpiProj, pg8::StaticOrder, true, true>(lds, g, S, E); }
    xcd_barrier(bar);
    pool_rows(proj, ymix, gw, NGW, lane);
    for (int it = bx; it < 4096; it += G) hgrn_local_item(proj, LT, DV, lds, it, tid);
    xcd_barrier(bar);
    hgrn_state_scan(LT, DV, bx * (NWAVES * 64) + tid, G * NWAVES * 64);
    xcd_barrier(bar);
    { HoP PA, PB; int it = bx;
      if (it < 4096) hgrn_out_loadp(proj, it, tid, PA);
      for (; it < 4096; it += 2 * G) {
          hgrn_out_item(proj, LT, args.in[10], ymix, lds, it, tid, PA, it + G, PB);
          if (it + G < 4096) hgrn_out_item(proj, LT, args.in[10], ymix, lds, it + G, tid, PB, it + 2 * G, PA); } }
    xcd_barrier(bar);
    { pg8::Gemm g{ymix, (const bf16*)(ws + WS_WOUT), M, D, D}; pg8::StaticOrder S; S.init(M, D, G, bx);
      pg8::EpiResid E{actb, ssq + 2 * M, 1.0f, D};
      pg8::gemm_phase<pg8::EpiResid, pg8::StaticOrder, true, true>(lds, g, S, E); }
    xcd_barrier(bar);
    { pg8::Gemm g{actb, (const bf16*)(ws + WS_WGU2), M, 2 * FF, D}; pg8::StaticOrder S; S.init(M, 2 * FF, G, bx);
      pg8::EpiSwiglu E{hid, FF, ssq + 2 * M};
      pg8::gemm_phase<pg8::EpiSwiglu, pg8::StaticOrder, true, true>(lds, g, S, E); }
    xcd_barrier(bar);
    { pg8::Gemm g{hid, (const bf16*)(ws + WS_WD2), M, D, FF}; pg8::StaticOrder S; S.init(M, D, G, bx, 1);
      pg8::EpiResid E{actb, ssq + 3 * M, 0.5f, D};
      pg8::gemm_phase<pg8::EpiResid, pg8::StaticOrder, true, true>(lds, g, S, E); }
    xcd_barrier(bar);
    final_norm(actb, args.out, ssq + 3 * M, args.in[16], gw, NGW, lane);
}

extern "C" void kernel_launch(void* const* d_in, const int* in_sizes, int n_in, void* d_out, int out_size, void* d_ws, size_t ws_size, hipStream_t stream) {
    static int grid = 0;
    if (grid == 0) {
        if (n_in != 17 || in_sizes[0] != M * D || out_size != M * D || ws_size < WS_END) { fprintf(stderr, "kernel_launch: unexpected shapes: n_in %d in0 %d out %d ws %zu\n", n_in, n_in > 0 ? in_sizes[0] : -1, out_size, ws_size); grid = -1; return; }
        int dev = 0, cus = 0, per_cu = 0;
        if (hipGetDevice(&dev) != hipSuccess || hipDeviceGetAttribute(&cus, hipDeviceAttributeMultiprocessorCount, dev) != hipSuccess) { grid = -1; return; }
        if (hipFuncSetAttribute((const void*)mk_fwd, hipFuncAttributeMaxDynamicSharedMemorySize, LDS_BYTES) != hipSuccess) { fprintf(stderr, "kernel_launch: hipFuncSetAttribute failed\n"); grid = -1; return; }
        if (hipOccupancyMaxActiveBlocksPerMultiprocessor(&per_cu, (const void*)mk_fwd, NWAVES * 64, LDS_BYTES) != hipSuccess || per_cu < 1) { fprintf(stderr, "kernel_launch: occupancy query says %d\n", per_cu); per_cu = 1; }
        (void)hipGetLastError();
        grid = cus * 1;
    }
    if (grid < 0) return;
    if (hipMemsetAsync((char*)d_ws + WS_BAR, 0, 16384, stream) != hipSuccess) { fprintf(stderr, "kernel_launch: memset of barrier words failed\n"); return; }
    Args a{};
    for (int i = 0; i < 17; ++i) a.in[i] = (const float*)d_in[i];
    a.out = (float*)d_out; a.ws = (unsigned char*)d_ws;
    void* kargs[] = {&a};
    hipError_t e = hipLaunchCooperativeKernel((const void*)mk_fwd, dim3(grid), dim3(NWAVES * 64), kargs, LDS_BYTES, stream);
    if (e != hipSuccess) fprintf(stderr, "kernel_launch: cooperative launch failed: %s (grid %d)\n", hipGetErrorString(e), grid);
}
```

```cpp
#include <hip/hip_runtime.h>
#include <hip/hip_cooperative_groups.h>
#include <cstdio>
#include <cstdint>
namespace cg = cooperative_groups;
namespace pg8 {
#define PG8_LAS __attribute__((address_space(3)))
typedef unsigned short bf16_t;
typedef short bf16x8 __attribute__((ext_vector_type(8)));
typedef float f32x4 __attribute__((ext_vector_type(4)));
typedef unsigned u32x4 __attribute__((ext_vector_type(4)));
constexpr int BM = 256, BK = 64, HALF = 128, HTB = HALF * BK * 2  , STAGE_BYTES = 8 * HTB, NXCD = 8, WGM = 8;

__host__ __device__ __forceinline__ int lds_byte(int r, int c) { const int st = (r >> 4) * 2 + (c >> 5), rr = r & 15, cc = c & 31, ob = rr * 64 + cc * 2; return st * 1024 + (ob ^ (((ob >> 9) & 1) << 5)); }
__host__ __device__ __forceinline__ void stage_rc(int b, int& R, int& C) { const int st = b / 1024, sb = b % 1024, swz = sb ^ (((sb >> 9) & 1) << 5); R = (st >> 1) * 16 + swz / 64; C = (st & 1) * 32 + (swz % 64) / 2; }
__host__ __device__ __forceinline__ int perm32(int rho) { const int n = rho >> 4, i = rho & 15; return 8 * (i >> 2) + 4 * n + (i & 3); }

struct Unit { int pm, pn; };
struct Gemm { const bf16_t* A; const bf16_t* Bt; int M, N, K; };

struct StaticOrder {
    int nM, nN, nwg, G, c, rev;
    __host__ __device__ void init(int M, int N, int G_, int c_, int rev_ = 0) { nM = M / BM; nN = N / BM; nwg = nM * nN; G = G_; c = c_; rev = rev_; }
    __host__ __device__ bool next(int i, Unit& u) const {
        const long L = (long)i * G + c; if (L >= nwg) return false;
        int wgid = (int)L; { const int q = nwg / NXCD, r = nwg % NXCD, xcd = wgid % NXCD; int off = wgid / NXCD; if (rev && r == 0) off = q - 1 - off; wgid = (xcd < r ? xcd * (q + 1) : r * (q + 1) + (xcd - r) * q) + off; }
        const int nig = WGM * nN, gid = wgid / nig, fm = gid * WGM, gsz = (nM - fm) < WGM ? (nM - fm) : WGM;
        u.pm = fm + ((wgid % nig) % gsz); u.pn = (wgid % nig) / gsz; return true;
    }
    __device__ __forceinline__ void a_ready(const Unit&) const {}
    __device__ __forceinline__ void done(const Unit&) const {}
};
typedef float f32x2 __attribute__((ext_vector_type(2)));
typedef __bf16 bf16x2_t __attribute__((ext_vector_type(2)));
__device__ __forceinline__ unsigned cvt_pk_bf16(float lo, float hi) { f32x2 v = {lo, hi}; bf16x2_t b = __builtin_convertvector(v, bf16x2_t); return __builtin_bit_cast(unsigned, b); }

constexpr float RMS_EPS = 1e-6f;
__device__ __forceinline__ float fast_sigmoid(float v) { return __builtin_amdgcn_rcpf(1.0f + __expf(-v)); }
__device__ __forceinline__ float silu_f(float v) { return v * fast_sigmoid(v); }

struct EpiSwiglu {
    static constexpr bool PERM = true, AFTER_DRAIN = false;
    bf16_t* O; int ldc; const float* ssq;
    __device__ __forceinline__ void operator()(const f32x4 (&acc)[2][2][4][2], const Unit& u, int wr, int wc, int fr, int fq) const {
        const int row0 = u.pm * BM + wr * 64 + fr, col0 = u.pn * HALF + wc * 32 + 8 * fq;
#pragma unroll
        for (int ai = 0; ai < 2; ++ai)
#pragma unroll
            for (int m = 0; m < 4; ++m) { const int row = row0 + ai * HALF + m * 16;
                const float r = __builtin_amdgcn_rsqf(ssq[row] * (1.0f / 1024.0f) + RMS_EPS);
                float h[8];
#pragma unroll
                for (int n = 0; n < 2; ++n)
#pragma unroll
                    for (int e = 0; e < 4; ++e) { const float g = acc[ai][0][m][n][e] * r, up = acc[ai][1][m][n][e] * r; h[4 * n + e] = silu_f(g) * up; }
                u32x4 w; w.x = cvt_pk_bf16(h[0], h[1]); w.y = cvt_pk_bf16(h[2], h[3]); w.z = cvt_pk_bf16(h[4], h[5]); w.w = cvt_pk_bf16(h[6], h[7]);
                *(u32x4*)(O + (size_t)row * ldc + col0) = w; }
    }
};
struct EpiResid {
    static constexpr bool PERM = true, AFTER_DRAIN = false;
    bf16_t* hb; float* ssq_out; float scale; int ldc;
    __device__ __forceinline__ void operator()(const f32x4 (&acc)[2][2][4][2], const Unit& u, int wr, int wc, int fr, int fq) const {
        const int row0 = u.pm * BM + wr * 64 + fr, col0 = u.pn * BM + wc * 32 + 8 * fq;
#pragma unroll
        for (int ai = 0; ai < 2; ++ai)
#pragma unroll
            for (int m = 0; m < 4; ++m) { const int row = row0 + ai * HALF + m * 16; const size_t off = (size_t)row * ldc + col0; float s = 0.f;
                u32x4 bw[2];
#pragma unroll
                for (int bj = 0; bj < 2; ++bj) bw[bj] = *(const u32x4*)(hb + off + bj * HALF);
#pragma unroll
                for (int bj = 0; bj < 2; ++bj) {
                    const f32x4 b0 = (f32x4){__uint_as_float(bw[bj].x << 16), __uint_as_float(bw[bj].x & 0xffff0000u), __uint_as_float(bw[bj].y << 16), __uint_as_float(bw[bj].y & 0xffff0000u)};
                    const f32x4 b1 = (f32x4){__uint_as_float(bw[bj].z << 16), __uint_as_float(bw[bj].z & 0xffff0000u), __uint_as_float(bw[bj].w << 16), __uint_as_float(bw[bj].w & 0xffff0000u)};
                    const f32x4 v0 = b0 + acc[ai][bj][m][0] * scale, v1 = b1 + acc[ai][bj][m][1] * scale;
                    u32x4 w; w.x = cvt_pk_bf16(v0[0], v0[1]); w.y = cvt_pk_bf16(v0[2], v0[3]); w.z = cvt_pk_bf16(v1[0], v1[1]); w.w = cvt_pk_bf16(v1[2], v1[3]);
                    *(u32x4*)(hb + off + bj * HALF) = w;
                    s += (v0[0] * v0[0] + v0[1] * v0[1]) + (v0[2] * v0[2] + v0[3] * v0[3]) + (v1[0] * v1[0] + v1[1] * v1[1]) + (v1[2] * v1[2] + v1[3] * v1[3]); }
                s += __shfl_xor(s, 16); s += __shfl_xor(s, 32);
                if (fq == 0) unsafeAtomicAdd(ssq_out + row, s); }
    }
};
struct EpiProj {
    static constexpr bool PERM = true, AFTER_DRAIN = false;
    bf16_t* O; int ldc; const float* ssq; const float* omlb;
    __device__ __forceinline__ void operator()(const f32x4 (&acc)[2][2][4][2], const Unit& u, int wr, int wc, int fr, int fq) const {
        const int row0 = u.pm * BM + wr * 64 + fr, col0 = u.pn * BM + wc * 32 + 8 * fq; const int type = u.pn >> 1;
        float ol[2][8];
#pragma unroll
        for (int bj = 0; bj < 2; ++bj)
#pragma unroll
            for (int e = 0; e < 8; ++e) ol[bj][e] = (type == 3 || type == 4) ? omlb[col0 + bj * HALF + e - 1536] : 0.f;
#pragma unroll
        for (int ai = 0; ai < 2; ++ai)
#pragma unroll
            for (int m = 0; m < 4; ++m) { const int row = row0 + ai * HALF + m * 16;
                const float r = __builtin_amdgcn_rsqf(ssq[row] * (1.0f / 1024.0f) + RMS_EPS);
#pragma unroll
                for (int bj = 0; bj < 2; ++bj) { float h[8];
#pragma unroll
                    for (int n = 0; n < 2; ++n)
#pragma unroll
                        for (int e = 0; e < 4; ++e) { const float v = acc[ai][bj][m][n][e] * r; float o = v;
                            if (type == 1 || type == 5) o = silu_f(v);
                            if (type == 3 || type == 4) o = ol[bj][4 * n + e] * __builtin_amdgcn_rcpf(1.0f + __expf(v));
                            h[4 * n + e] = o; }
                    u32x4 w; w.x = cvt_pk_bf16(h[0], h[1]); w.y = cvt_pk_bf16(h[2], h[3]); w.z = cvt_pk_bf16(h[4], h[5]); w.w = cvt_pk_bf16(h[6], h[7]);
                    u32x4* dst = (u32x4*)(O + (size_t)row * ldc + col0 + bj * HALF);
                    if (type == 1 || type == 5) __builtin_nontemporal_store(w, dst); else *dst = w; } }
    }
};
struct EpiPlain {
    static constexpr bool PERM = true, AFTER_DRAIN = false;
    bf16_t* O; int ldc;
    __device__ __forceinline__ void operator()(const f32x4 (&acc)[2][2][4][2], const Unit& u, int wr, int wc, int fr, int fq) const {
        const int row0 = u.pm * BM + wr * 64 + fr, col0 = u.pn * BM + wc * 32 + 8 * fq;
#pragma unroll
        for (int ai = 0; ai < 2; ++ai)
#pragma unroll
            for (int m = 0; m < 4; ++m) { const int row = row0 + ai * HALF + m * 16;
#pragma unroll
                for (int bj = 0; bj < 2; ++bj) { const f32x4 v0 = acc[ai][bj][m][0], v1 = acc[ai][bj][m][1];
                    u32x4 w; w.x = cvt_pk_bf16(v0[0], v0[1]); w.y = cvt_pk_bf16(v0[2], v0[3]); w.z = cvt_pk_bf16(v1[0], v1[1]); w.w = cvt_pk_bf16(v1[2], v1[3]);
                    *(u32x4*)(O + (size_t)row * ldc + col0 + bj * HALF) = w; } }
    }
};

template <class Epi, class Sched, bool ALIGN_EPI = false, bool SP2 = false>
__device__ __forceinline__ void gemm_phase(PG8_LAS unsigned char* lds, const Gemm g, const Sched& S, const Epi& E) {
    const int tid = threadIdx.x, wid = __builtin_amdgcn_readfirstlane(tid >> 6), lane = tid & 63, wr = wid >> 2, wc = wid & 3, fr = lane & 15, fq = lane >> 4;
    const int K = g.K, nt = K / BK;
    unsigned voffA[2], voffB[2];
#pragma unroll
    for (int i = 0; i < 2; ++i) { int R, C; stage_rc(tid * 16 + i * 8192, R, C); const int Rb = Epi::PERM ? ((R & ~31) + perm32(R & 31)) : R;
        voffA[i] = (unsigned)(R * K + C) * 2u; voffB[i] = (unsigned)(Rb * K + C) * 2u; }
    const size_t kstep = (size_t)(BK * 2);
    const size_t hstep = (size_t)HALF * K * 2;
    const size_t tstep = 2 * hstep;
    const unsigned ldsw = (unsigned)wid * 1024u;
    const int aoff = lds_byte(wr * 64 + fr, fq * 8), boff = lds_byte(wc * 32 + fr, fq * 8);
#define PG8_SA(b, h) (((b) * 2 + (h)) * HTB)
#define PG8_SB(b, h) ((4 + (b) * 2 + (h)) * HTB)
#define PG8_STAGE(bufoff, gbase, voff) do { _Pragma("unroll") for (int _i = 0; _i < 2; ++_i) \
        __builtin_amdgcn_global_load_lds((const unsigned*)((const char*)(gbase) + (voff)[_i]), (PG8_LAS unsigned*)(lds + (bufoff) + ldsw + _i * 8192), 16, 0, 0); } while (0)
#define PG8_LDA(dst, b, h) do { _Pragma("unroll") for (int m = 0; m < 4; ++m) _Pragma("unroll") for (int k = 0; k < 2; ++k) dst[m][k] = *(const PG8_LAS bf16x8*)(lds + PG8_SA(b, h) + aoff + m * 2048 + k * 1024); } while (0)
#define PG8_LDB(dst, b, h) do { _Pragma("unroll") for (int n = 0; n < 2; ++n) _Pragma("unroll") for (int k = 0; k < 2; ++k) dst[n][k] = *(const PG8_LAS bf16x8*)(lds + PG8_SB(b, h) + boff + n * 2048 + k * 1024); } while (0)
#define PG8_MMA(ai, bj, At, Bt) do { __builtin_amdgcn_s_setprio(1); _Pragma("unroll") for (int m = 0; m < 4; ++m) _Pragma("unroll") for (int n = 0; n < 2; ++n) _Pragma("unroll") for (int k = 0; k < 2; ++k) \
        acc[ai][bj][m][n] = __builtin_amdgcn_mfma_f32_16x16x32_bf16(Bt[n][k], At[m][k], acc[ai][bj][m][n], 0, 0, 0); __builtin_amdgcn_s_setprio(0); } while (0)
#define PG8_WAIT_V(n) asm volatile("s_waitcnt vmcnt(" #n ")" ::: "memory")
#define PG8_WAIT_L(n) asm volatile("s_waitcnt lgkmcnt(" #n ")" ::: "memory")
#define PG8_BAR __builtin_amdgcn_s_barrier()
#define PG8_SCHED __builtin_amdgcn_sched_barrier(0)
    Unit cur, nxt; int ui = 0;
    if (!S.next(0, cur)) return;
    f32x4 acc[2][2][4][2];
#pragma unroll
    for (int a = 0; a < 2; ++a)
#pragma unroll
        for (int b = 0; b < 2; ++b)
#pragma unroll
            for (int m = 0; m < 4; ++m)
#pragma unroll
                for (int n = 0; n < 2; ++n) acc[a][b][m][n] = (f32x4){0.f, 0.f, 0.f, 0.f};
    bf16x8 At[4][2], B0[2][2], B1[2][2];
    const char* cA = (const char*)g.A + (size_t)cur.pm * tstep; const char* cB = (const char*)g.Bt + (size_t)cur.pn * tstep;
    S.a_ready(cur);
    if constexpr (SP2) {
        PG8_STAGE(PG8_SB(0, 0), cB, voffB); PG8_STAGE(PG8_SB(0, 1), cB + hstep, voffB); PG8_STAGE(PG8_SA(0, 0), cA, voffA); PG8_STAGE(PG8_SA(0, 1), cA + hstep, voffA);
        if (wr == 1) PG8_BAR;
        PG8_WAIT_V(2); PG8_BAR;
        PG8_STAGE(PG8_SB(1, 0), cB + kstep, voffB); PG8_STAGE(PG8_SA(1, 0), cA + kstep, voffA); PG8_STAGE(PG8_SB(1, 1), cB + hstep + kstep, voffB);
        PG8_WAIT_V(6); PG8_BAR;
    } else {
        PG8_STAGE(PG8_SB(0, 0), cB, voffB); PG8_STAGE(PG8_SA(0, 0), cA, voffA); PG8_STAGE(PG8_SB(0, 1), cB + hstep, voffB); PG8_STAGE(PG8_SA(0, 1), cA + hstep, voffA);
        if (wr == 1) PG8_BAR;
        PG8_WAIT_V(4); PG8_BAR;
        PG8_STAGE(PG8_SB(1, 0), cB + kstep, voffB); PG8_STAGE(PG8_SA(1, 0), cA + kstep, voffA); PG8_STAGE(PG8_SB(1, 1), cB + hstep + kstep, voffB);
        PG8_WAIT_V(6); PG8_BAR;
    }
    for (;;) {
        const bool has_next = S.next(ui + 1, nxt);
        const char* nA = has_next ? (const char*)g.A + (size_t)nxt.pm * tstep : cA; const char* nB = has_next ? (const char*)g.Bt + (size_t)nxt.pn * tstep : cB;
        for (int t = 0; t < nt; t += 2) {
            const bool last = (t == nt - 2);
            const char* a1 = cA + (size_t)(t + 1) * kstep;
            const char* a2 = last ? nA : cA + (size_t)(t + 2) * kstep; const char* b2 = last ? nB : cB + (size_t)(t + 2) * kstep;
            const char* a3 = a2 + kstep; const char* b3 = b2 + kstep;
            if (last && has_next) S.a_ready(nxt);
            if constexpr (SP2) {
            PG8_LDB(B0, 0, 0); PG8_LDB(B1, 0, 1); PG8_SCHED; PG8_LDA(At, 0, 0); PG8_STAGE(PG8_SA(1, 1), a1 + hstep, voffA);
            PG8_WAIT_V(8); PG8_WAIT_L(0); PG8_BAR; PG8_MMA(0, 0, At, B0); PG8_MMA(0, 1, At, B1); PG8_BAR; PG8_SCHED;
            PG8_LDA(At, 0, 1); PG8_STAGE(PG8_SB(0, 0), b2, voffB); PG8_STAGE(PG8_SB(0, 1), b2 + hstep, voffB); PG8_STAGE(PG8_SA(0, 0), a2, voffA);
            PG8_WAIT_V(8); PG8_WAIT_L(0); PG8_BAR; PG8_MMA(1, 0, At, B0); PG8_MMA(1, 1, At, B1); PG8_BAR; PG8_SCHED;
            PG8_LDB(B0, 1, 0); PG8_LDB(B1, 1, 1); PG8_SCHED; PG8_LDA(At, 1, 0); PG8_STAGE(PG8_SA(0, 1), a2 + hstep, voffA);
            PG8_WAIT_V(8); PG8_WAIT_L(0); PG8_BAR; PG8_MMA(0, 0, At, B0); PG8_MMA(0, 1, At, B1); PG8_BAR; PG8_SCHED;
            PG8_LDA(At, 1, 1); PG8_STAGE(PG8_SB(1, 0), b3, voffB); PG8_STAGE(PG8_SB(1, 1), b3 + hstep, voffB); PG8_STAGE(PG8_SA(1, 0), a3, voffA);
            PG8_WAIT_V(8); PG8_WAIT_L(0); PG8_BAR; PG8_MMA(1, 0, At, B0); PG8_MMA(1, 1, At, B1); PG8_BAR; PG8_SCHED;
            } else {
            PG8_LDB(B0, 0, 0); PG8_SCHED; PG8_LDA(At, 0, 0); PG8_STAGE(PG8_SA(1, 1), a1 + hstep, voffA);
            PG8_WAIT_L(8); PG8_BAR; PG8_WAIT_L(0); PG8_MMA(0, 0, At, B0); PG8_BAR; PG8_SCHED;
            PG8_LDB(B1, 0, 1); PG8_STAGE(PG8_SB(0, 0), b2, voffB);
            PG8_BAR; PG8_WAIT_L(0); PG8_MMA(0, 1, At, B1); PG8_BAR;
            PG8_LDA(At, 0, 1); PG8_STAGE(PG8_SA(0, 0), a2, voffA);
            PG8_BAR; PG8_WAIT_L(0); PG8_MMA(1, 0, At, B0); PG8_BAR; PG8_SCHED;
            PG8_STAGE(PG8_SB(0, 1), b2 + hstep, voffB);
            PG8_WAIT_V(6); PG8_BAR; PG8_MMA(1, 1, At, B1); PG8_BAR;
            PG8_LDB(B0, 1, 0); PG8_SCHED; PG8_LDA(At, 1, 0); PG8_STAGE(PG8_SA(0, 1), a2 + hstep, voffA);
            PG8_WAIT_L(8); PG8_BAR; PG8_WAIT_L(0); PG8_MMA(0, 0, At, B0); PG8_BAR; PG8_SCHED;
            PG8_LDB(B1, 1, 1); PG8_STAGE(PG8_SB(1, 0), b3, voffB);
            PG8_BAR; PG8_WAIT_L(0); PG8_MMA(0, 1, At, B1); PG8_BAR;
            PG8_LDA(At, 1, 1); PG8_STAGE(PG8_SA(1, 0), a3, voffA);
            PG8_BAR; PG8_WAIT_L(0); PG8_MMA(1, 0, At, B0); PG8_BAR; PG8_SCHED;
            PG8_STAGE(PG8_SB(1, 1), b3 + hstep, voffB);
            PG8_WAIT_V(6); PG8_BAR; PG8_MMA(1, 1, At, B1); PG8_BAR;
            }
        }
        if constexpr (ALIGN_EPI) { if (wr == 0) PG8_BAR; }
        if constexpr (!Epi::AFTER_DRAIN) { E(acc, cur, wr, wc, fr, fq); S.done(cur); }
        if (!has_next) break;
#pragma unroll
        for (int a = 0; a < 2; ++a)
#pragma unroll
            for (int b = 0; b < 2; ++b)
#pragma unroll
                for (int m = 0; m < 4; ++m)
#pragma unroll
                    for (int n = 0; n < 2; ++n) acc[a][b][m][n] = (f32x4){0.f, 0.f, 0.f, 0.f};
        cur = nxt; cA = nA; cB = nB; ++ui;
        if constexpr (ALIGN_EPI) { if (wr == 1) PG8_BAR; }
    }
    PG8_WAIT_V(0);
    if constexpr (!ALIGN_EPI) { if (wr == 0) PG8_BAR; }
    PG8_BAR;
    if constexpr (Epi::AFTER_DRAIN) { E.fused(acc, cur, wr, wc, fr, fq, lds, wid, lane); S.done(cur); }
#undef PG8_SA
#undef PG8_SB
#undef PG8_STAGE
#undef PG8_LDA
#undef PG8_LDB
#undef PG8_MMA
#undef PG8_WAIT_V
#undef PG8_WAIT_L
#undef PG8_BAR
#undef PG8_SCHED
}
}

constexpr int NWAVES = 8;
constexpr int BATCH = 8, SEQ = 8192, D = 1024, FF = 2816, INC = 3072, PW = 512, HW = 512, HD = 128;
constexpr int M = BATCH * SEQ;
constexpr float EPS = 1e-6f;
constexpr size_t MiB = 1u << 20;
constexpr size_t WS_SSQ = 0;
constexpr size_t WS_BAR = 1 * MiB + 512 * 1024;
constexpr size_t WS_OMLB = 1 * MiB;
constexpr size_t WS_WGU1 = 2 * MiB;
constexpr size_t WS_WD1 = 13 * MiB;
constexpr size_t WS_WIN = 19 * MiB;
constexpr size_t WS_WOUT = 25 * MiB;
constexpr size_t WS_WGU2 = 27 * MiB;
constexpr size_t WS_WD2 = 38 * MiB;
constexpr size_t WS_WPOOL = 44 * MiB;
constexpr size_t WS_ACTB = 48 * MiB;
constexpr size_t WS_YMIX = 176 * MiB;
constexpr size_t WS_PROJ = 304 * MiB;
constexpr size_t WS_LT = 688 * MiB;
constexpr size_t WS_POOLED = 944 * MiB;
constexpr size_t WS_END = 1008 * MiB;
constexpr int LDS_BYTES = 147456;

#define LAS __attribute__((address_space(3)))
typedef unsigned short bf16;
typedef unsigned v4u __attribute__((ext_vector_type(4)));
typedef unsigned v2u __attribute__((ext_vector_type(2)));
typedef float f32x4 __attribute__((ext_vector_type(4)));
typedef float f32x2 __attribute__((ext_vector_type(2)));
#define LDS_WAIT() asm volatile("s_waitcnt lgkmcnt(0)" ::: "memory")
__device__ __forceinline__ unsigned pk2(float lo, float hi) { return pg8::cvt_pk_bf16(lo, hi); }
__device__ __forceinline__ float bflo(unsigned w) { return __uint_as_float(w << 16); }
__device__ __forceinline__ float bfhi(unsigned w) { return __uint_as_float(w & 0xffff0000u); }
__device__ __forceinline__ float wave_sum(float v) {
#pragma unroll
    for (int o = 1; o < 64; o <<= 1) v += __shfl_xor(v, o);
    return v;
}

__device__ __forceinline__ void transpose_item(const float* W, int N, bf16* WT, int ldk, int koff, int mode, int rowoff, const float* ks, const float* ns, LAS float* scr, int item, int lane) {
    const int nblk = N / 32, kb = item / nblk, nb = item % nblk, k0 = 64 * kb, n0 = 32 * nb;
#pragma unroll
    for (int i = 0; i < 32; ++i) { const int kk = 2 * i + (lane >> 5); float w = __builtin_nontemporal_load(W + (size_t)(k0 + kk) * N + n0 + (lane & 31)); if (ks) w *= ks[k0 + kk]; scr[kk * 33 + (lane & 31)] = w; }
    LDS_WAIT(); asm volatile("" ::: "memory");
    const int c = lane & 7;
#pragma unroll
    for (int j = 0; j < 4; ++j) { const int n = (lane >> 3) + 8 * j; const LAS float* s = scr + (8 * c) * 33 + n; const float sc = ns ? ns[n0 + n] : 1.0f;
        v4u o; o.x = pk2(s[0 * 33] * sc, s[1 * 33] * sc); o.y = pk2(s[2 * 33] * sc, s[3 * 33] * sc); o.z = pk2(s[4 * 33] * sc, s[5 * 33] * sc); o.w = pk2(s[6 * 33] * sc, s[7 * 33] * sc);
        const int ng = n0 + n; const int drow = (mode == 1) ? (256 * (ng >> 7) + rowoff + (ng & 127)) : (rowoff + ng);
        *(v4u*)(WT + (size_t)drow * ldk + koff + k0 + 8 * c) = o; }
    LDS_WAIT(); asm volatile("" ::: "memory");
}

#define XB_TMO      128
#define XB_XCNT(j)  (256  + 64 * (j))
#define XB_XSUB(j)  (1280 + 64 * (j))
#define XB_XGEN(j)  (2304 + 64 * (j))
#define XB_TOP      3328
#define XB_TOPGEN   3392
#define XCD_BAR_WORDS 3456
#define XB_SPIN_CAP (1u << 18)

__device__ __forceinline__ unsigned xb_ld(unsigned* p)              { return __hip_atomic_load(p, __ATOMIC_RELAXED, __HIP_MEMORY_SCOPE_AGENT); }
__device__ __forceinline__ unsigned xb_add(unsigned* p, unsigned v) { return __hip_atomic_fetch_add(p, v, __ATOMIC_RELAXED, __HIP_MEMORY_SCOPE_AGENT); }
__device__ __forceinline__ unsigned xb_xcc_id() { return (unsigned)__builtin_amdgcn_s_getreg((3 << 11) | 20) & 0xFu; }
#define XB_SPIN(cond, bar) do { unsigned _sp = 0; while (cond) { __builtin_amdgcn_s_sleep(1); \
    if ((++_sp & 255u) == 0u) { if (xb_ld(&(bar)[XB_TMO])) break; if (_sp > XB_SPIN_CAP) { atomicAdd(&(bar)[XB_TMO], 1u); break; } } } } while (0)

struct XcdBarrier {
    unsigned* bar; unsigned x;
    volatile LAS unsigned* st;
};

__device__ __forceinline__ XcdBarrier xcd_barrier_post(unsigned* bar, volatile LAS unsigned* st) {
    XcdBarrier b; b.bar = bar; b.x = xb_xcc_id(); b.st = st;
    if (threadIdx.x == 0) (void)xb_add(&bar[XB_XCNT(b.x)], 1u);
    return b;
}
__device__ __forceinline__ void xcd_barrier_complete(unsigned* bar, unsigned x, unsigned& nloc, unsigned& nx) {
    const unsigned G = gridDim.x * gridDim.y * gridDim.z;
    unsigned sum, cnt, mine, sp = 0u;
    for (;;) {
        sum = 0u; cnt = 0u; mine = 0u;
#pragma unroll
        for (unsigned j = 0; j < 16; ++j) { const unsigned c = xb_ld(&bar[XB_XCNT(j)]); sum += c; cnt += (c > 0u) ? 1u : 0u; mine = (j == x) ? c : mine; }
        if (sum == G) break;
        __builtin_amdgcn_s_sleep(1);
        if ((++sp & 255u) == 0u) { if (xb_ld(&bar[XB_TMO])) break; if (sp > XB_SPIN_CAP) { atomicAdd(&bar[XB_TMO], 1u); break; } }
    }
    nloc = mine > 0u ? mine : 1u; nx = cnt > 0u ? cnt : 1u;
}

__device__ __forceinline__ void xcd_barrier(const XcdBarrier& b) {
    asm volatile("s_waitcnt vmcnt(0)" ::: "memory");
    __syncthreads();
    if (threadIdx.x == 0) {
        unsigned* bar = b.bar;
        __builtin_amdgcn_s_waitcnt(0);
        unsigned nloc = b.st[0], nx = b.st[1];
        if (nloc == 0u) { xcd_barrier_complete(bar, b.x, nloc, nx); b.st[0] = nloc; b.st[1] = nx; }
        const unsigned old = xb_add(&bar[XB_XSUB(b.x)], 1u);
        const unsigned gen = old / nloc;
        if (old + 1u == (gen + 1u) * nloc) {
            __builtin_amdgcn_fence(__ATOMIC_RELEASE, "agent");
            asm volatile("s_waitcnt vmcnt(0)" ::: "memory");
            const unsigned og = xb_add(&bar[XB_TOP], 1u);
            const unsigned tg = og / nx;
            if (og + 1u == (tg + 1u) * nx) xb_add(&bar[XB_TOPGEN], 1u);
            else XB_SPIN(xb_ld(&bar[XB_TOPGEN]) == tg, bar);
            __builtin_amdgcn_fence(__ATOMIC_ACQUIRE, "agent");
            xb_add(&bar[XB_XGEN(b.x)], 1u);
            asm volatile("s_waitcnt vmcnt(0)" ::: "memory");
        } else {
            XB_SPIN(xb_ld(&bar[XB_XGEN(b.x)]) == gen, bar);
            __builtin_amdgcn_fence(__ATOMIC_ACQUIRE, "agent");
            asm volatile("s_waitcnt vmcnt(0)" ::: "memory");
        }
    }
    __syncthreads();
}

struct Args { const float* in[17]; float* out; unsigned char* ws; };

__device__ __forceinline__ void p0_prologue(const Args& a, LAS unsigned char* lds, int gw, int NGW, int wave, int lane) {
    unsigned char* ws = a.ws;
    LAS float* scr = (LAS float*)(lds + wave * 16384);
    constexpr int I_GU = (D / 64) * (FF / 32), I_DN = (FF / 64) * (D / 32), I_IN = (D / 64) * (INC / 32), I_OUT = (HW / 64) * (D / 32);
    constexpr int NITEMS = 4 * I_GU + 2 * I_DN + I_IN + I_OUT;
    for (int it = gw; it < NITEMS; it += NGW) {
        int r = it;
        if (r < I_GU) { transpose_item(a.in[2], FF, (bf16*)(ws + WS_WGU1), D, 0, 1, 0, a.in[1], nullptr, scr, r, lane); continue; } r -= I_GU;
        if (r < I_GU) { transpose_item(a.in[3], FF, (bf16*)(ws + WS_WGU1), D, 0, 1, 128, a.in[1], nullptr, scr, r, lane); continue; } r -= I_GU;
        if (r < I_GU) { transpose_item(a.in[13], FF, (bf16*)(ws + WS_WGU2), D, 0, 1, 0, a.in[12], nullptr, scr, r, lane); continue; } r -= I_GU;
        if (r < I_GU) { transpose_item(a.in[14], FF, (bf16*)(ws + WS_WGU2), D, 0, 1, 128, a.in[12], nullptr, scr, r, lane); continue; } r -= I_GU;
        if (r < I_DN) { transpose_item(a.in[4], D, (bf16*)(ws + WS_WD1), FF, 0, 0, 0, nullptr, nullptr, scr, r, lane); continue; } r -= I_DN;
        if (r < I_DN) { transpose_item(a.in[15], D, (bf16*)(ws + WS_WD2), FF, 0, 0, 0, nullptr, nullptr, scr, r, lane); continue; } r -= I_DN;
        if (r < I_IN) { transpose_item(a.in[6], INC, (bf16*)(ws + WS_WIN), D, 0, 0, 0, a.in[5], nullptr, scr, r, lane); continue; } r -= I_IN;
        transpose_item(a.in[11], D, (bf16*)(ws + WS_WOUT), D, 0, 0, 0, nullptr, nullptr, scr, r + (PW / 64) * (D / 32), lane);
    }
    for (int wi = gw; wi < 2048; wi += NGW) {
        const int n = (wi & 15) * 64 + lane, kq = wi >> 4, g = kq >> 5, c0 = (kq & 31) * 4;
        const float* wo = a.in[11] + (size_t)(g * 128) * D + n; const float* pw = a.in[7] + (size_t)(g * 128 + c0) * 128; const float* ps = a.in[8] + g * 128;
        f32x4 acc4 = (f32x4){0.f, 0.f, 0.f, 0.f};
#pragma unroll 8
        for (int d = 0; d < 128; d += 4) {
            const f32x4 p4 = *(const f32x4*)(ps + d);
            const f32x4 w4 = (f32x4){wo[(size_t)d * D], wo[(size_t)(d + 1) * D], wo[(size_t)(d + 2) * D], wo[(size_t)(d + 3) * D]} * p4;
#pragma unroll
            for (int e = 0; e < 4; ++e) { const f32x4 q4 = *(const f32x4*)(pw + e * 128 + d); acc4[e] += (w4[0] * q4[0] + w4[1] * q4[1]) + (w4[2] * q4[2] + w4[3] * q4[3]); } }
        *(v2u*)((bf16*)(ws + WS_WOUT) + (size_t)n * D + kq * 4) = (v2u){pk2(acc4[0], acc4[1]), pk2(acc4[2], acc4[3])};
    }
    const float* x = a.in[0]; bf16* xb = (bf16*)(ws + WS_ACTB); float* ssq = (float*)(ws + WS_SSQ);
    for (int m = gw; m < M; m += NGW) {
        const f32x4* xr = (const f32x4*)(x + (size_t)m * D) + lane; f32x4 v[4]; float s = 0.f;
#pragma unroll
        for (int j = 0; j < 4; ++j) { v[j] = __builtin_nontemporal_load(xr + 64 * j); s += (v[j].x * v[j].x + v[j].y * v[j].y) + (v[j].z * v[j].z + v[j].w * v[j].w); }
        s = wave_sum(s);
        v2u* o8 = (v2u*)(xb + (size_t)m * D) + lane;
#pragma unroll
        for (int j = 0; j < 4; ++j) o8[64 * j] = (v2u){pk2(v[j].x, v[j].y), pk2(v[j].z, v[j].w)};
        if (lane == 0) { ssq[m] = s; ssq[M + m] = 0.f; ssq[2 * M + m] = 0.f; ssq[3 * M + m] = 0.f; }
    }
    if (gw < 16) { const int i = gw * 64 + lane; const int d = i >> 9, w = i & 511; const float a0 = a.in[9][d * 1024 + w], a1 = a.in[9][d * 1024 + 512 + w];
        ((float*)(ws + WS_OMLB))[i] = 1.0f / (1.0f + expf(a0 - a1)); }
}

__device__ __forceinline__ void pool_rows(const bf16* proj, bf16* pooled, int gw, int NGW, int lane) {
    const int g = lane >> 4, half = 1 << g;
    float mul[16];
#pragma unroll
    for (int d = 0; d < 16; ++d) mul[d] = (d - 8 >= -half && d - 8 < half) ? 1.0f : 0.0f;
    for (int blk = gw; blk < M / 8; blk += NGW) {
        const int m0 = blk * 8, t0 = m0 & (SEQ - 1);
        const bf16* base = proj + (size_t)(m0 - t0) * INC + lane * 8;
        v4u z[24];
#pragma unroll
        for (int j = 0; j < 24; ++j) { const int t = t0 - 8 + j; z[j] = (t >= 0 && t < SEQ) ? __builtin_nontemporal_load((const v4u*)(base + (size_t)t * INC)) : (v4u){0u, 0u, 0u, 0u}; }
#pragma unroll
        for (int r = 0; r < 8; ++r) {
            float s[8];
#pragma unroll
            for (int e = 0; e < 8; ++e) s[e] = 0.f;
#pragma unroll
            for (int d = 0; d < 16; ++d) { const v4u w = z[r + d]; const float ml = mul[d];
                s[0] += ml * bflo(w.x); s[1] += ml * bfhi(w.x); s[2] += ml * bflo(w.y); s[3] += ml * bfhi(w.y); s[4] += ml * bflo(w.z); s[5] += ml * bfhi(w.z); s[6] += ml * bflo(w.w); s[7] += ml * bfhi(w.w); }
            const int t = t0 + r; const int lo = (t - half) < 0 ? 0 : (t - half), hi = (t + half) > SEQ ? SEQ : (t + half);
            const float inv = 1.0f / (float)(hi - lo); const v4u zc = z[r + 8];
            v4u o; o.x = pk2(s[0] * inv - bflo(zc.x), s[1] * inv - bfhi(zc.x)); o.y = pk2(s[2] * inv - bflo(zc.y), s[3] * inv - bfhi(zc.y));
            o.z = pk2(s[4] * inv - bflo(zc.z), s[5] * inv - bfhi(zc.z)); o.w = pk2(s[6] * inv - bflo(zc.w), s[7] * inv - bfhi(zc.w));
            __builtin_nontemporal_store(o, (v4u*)(pooled + (size_t)(m0 + r) * D + lane * 8));
        }
    }
}

typedef short bf16x8 __attribute__((ext_vector_type(8)));
__device__ __forceinline__ f32x4 mfma16(bf16x8 x, bf16x8 y, f32x4 c) { return __builtin_amdgcn_mfma_f32_16x16x32_bf16(x, y, c, 0, 0, 0); }
constexpr int TR_STRIDE = 144;
constexpr int CH_STRIDE = 272;

__device__ __forceinline__ float fast_ln(float x) { return __builtin_amdgcn_logf(x) * 0.69314718f; }
constexpr float ST_SCALE = 8.0f, ST_INV = 1.0f / 8.0f, ST_MAX = 440.0f;
__device__ __forceinline__ float st_clamp(float x) { return fminf(fmaxf(x, -ST_MAX), ST_MAX); }
__device__ __forceinline__ unsigned pack_fp8x4(float a, float b, float c, float d) {
    int w = 0; w = __builtin_amdgcn_cvt_pk_fp8_f32(st_clamp(a), st_clamp(b), w, false); w = __builtin_amdgcn_cvt_pk_fp8_f32(st_clamp(c), st_clamp(d), w, true); return (unsigned)w; }
__device__ __forceinline__ f32x4 unpack_fp8x4(unsigned w) { const f32x2 lo = __builtin_amdgcn_cvt_pk_f32_fp8((int)w, false), hi = __builtin_amdgcn_cvt_pk_f32_fp8((int)w, true); return (f32x4){lo.x, lo.y, hi.x, hi.y}; }

struct HlP { unsigned rv[8], rkf[8], rkb[8]; };
__device__ __forceinline__ void hgrn_local_loadp(const bf16* proj, int it, int tid, HlP& P) {
    const int b = it >> 9, head = (it >> 7) & 3, c = it & 127, cp = tid & 63, pg = __builtin_amdgcn_readfirstlane(tid >> 6);
    const bf16* pv = proj + ((size_t)b * SEQ + c * 64 + pg * 8) * INC + 1024 + head * 128 + 2 * cp;
#pragma unroll
    for (int i = 0; i < 8; ++i) { P.rv[i] = __builtin_nontemporal_load((const unsigned*)(pv + (size_t)i * INC)); P.rkf[i] = __builtin_nontemporal_load((const unsigned*)(pv + (size_t)i * INC + 512)); P.rkb[i] = __builtin_nontemporal_load((const unsigned*)(pv + (size_t)i * INC + 1024)); }
}
__device__ __forceinline__ void hgrn_local_item(const bf16* proj, bf16* LT, float* DV, LAS unsigned char* lds, int it, int tid, const HlP& R, int it_next, HlP& NX) {
    const int b = it >> 9, head = (it >> 7) & 3, c = it & 127;
    const int cp = tid & 63, pg = __builtin_amdgcn_readfirstlane(tid >> 6), lane = tid & 63, fr = lane & 15, fq = lane >> 4;
    LAS unsigned char* VT = lds;
    LAS unsigned char* KF = lds + 128 * TR_STRIDE;
    LAS unsigned char* KB = lds + 2 * 128 * TR_STRIDE;
    LAS float* TF = (LAS float*)(lds + 3 * 128 * TR_STRIDE);
    LAS float* TB = TF + 1024;
    float gf[8][2], gb[8][2]; float tf0 = 0.f, tf1 = 0.f, tb0 = 0.f, tb1 = 0.f;
#pragma unroll
    for (int i = 0; i < 8; ++i) { gf[i][0] = fast_ln(1.0f - bflo(R.rkf[i])); gf[i][1] = fast_ln(1.0f - bfhi(R.rkf[i])); gb[i][0] = fast_ln(1.0f - bflo(R.rkb[i])); gb[i][1] = fast_ln(1.0f - bfhi(R.rkb[i]));
        tf0 += gf[i][0]; tf1 += gf[i][1]; tb0 += gb[i][0]; tb1 += gb[i][1]; }
    *(LAS f32x2*)(TF + pg * 128 + 2 * cp) = (f32x2){tf0, tf1}; *(LAS f32x2*)(TB + pg * 128 + 2 * cp) = (f32x2){tb0, tb1};
    { v4u w0, w1;
      w0.x = (R.rv[0] & 0xffffu) | (R.rv[1] << 16); w0.y = (R.rv[2] & 0xffffu) | (R.rv[3] << 16); w0.z = (R.rv[4] & 0xffffu) | (R.rv[5] << 16); w0.w = (R.rv[6] & 0xffffu) | (R.rv[7] << 16);
      w1.x = (R.rv[0] >> 16) | (R.rv[1] & 0xffff0000u); w1.y = (R.rv[2] >> 16) | (R.rv[3] & 0xffff0000u); w1.z = (R.rv[4] >> 16) | (R.rv[5] & 0xffff0000u); w1.w = (R.rv[6] >> 16) | (R.rv[7] & 0xffff0000u);
      *(LAS v4u*)(VT + (2 * cp) * TR_STRIDE + pg * 16) = w0; *(LAS v4u*)(VT + (2 * cp + 1) * TR_STRIDE + pg * 16) = w1; }
    __syncthreads();
    if (it_next >= 0) hgrn_local_loadp(proj, it_next, tid, NX);
    float af0 = 0.f, af1 = 0.f, bb0 = 0.f, bb1 = 0.f, sf0 = 0.f, sf1 = 0.f, sb0 = 0.f, sb1 = 0.f;
#pragma unroll
    for (int p = 0; p < 8; ++p) { const f32x2 a = *(const LAS f32x2*)(TF + p * 128 + 2 * cp), bq = *(const LAS f32x2*)(TB + p * 128 + 2 * cp);
        sf0 += a.x; sf1 += a.y; sb0 += bq.x; sb1 += bq.y; if (p > pg) { af0 += a.x; af1 += a.y; } if (p < pg) { bb0 += bq.x; bb1 += bq.y; } }
    const int seqf = (b * 4 + head) * 128 + c, seqb = ((32 + b * 4 + head)) * 128 + c;
    if (pg == 0) { *(f32x2*)(DV + (size_t)seqf * 128 + 2 * cp) = (f32x2){__expf(sf0), __expf(sf1)}; *(f32x2*)(DV + (size_t)seqb * 128 + 2 * cp) = (f32x2){__expf(sb0), __expf(sb1)}; }
    { float kd[8][2];
#pragma unroll
      for (int i = 7; i >= 0; --i) { kd[i][0] = bflo(R.rkf[i]) * __expf(af0); kd[i][1] = bfhi(R.rkf[i]) * __expf(af1); af0 += gf[i][0]; af1 += gf[i][1]; }
      v4u w0, w1; w0.x = pk2(kd[0][0], kd[1][0]); w0.y = pk2(kd[2][0], kd[3][0]); w0.z = pk2(kd[4][0], kd[5][0]); w0.w = pk2(kd[6][0], kd[7][0]);
      w1.x = pk2(kd[0][1], kd[1][1]); w1.y = pk2(kd[2][1], kd[3][1]); w1.z = pk2(kd[4][1], kd[5][1]); w1.w = pk2(kd[6][1], kd[7][1]);
      *(LAS v4u*)(KF + (2 * cp) * TR_STRIDE + pg * 16) = w0; *(LAS v4u*)(KF + (2 * cp + 1) * TR_STRIDE + pg * 16) = w1;
#pragma unroll
      for (int i = 0; i < 8; ++i) { kd[i][0] = bflo(R.rkb[i]) * __expf(bb0); kd[i][1] = bfhi(R.rkb[i]) * __expf(bb1); bb0 += gb[i][0]; bb1 += gb[i][1]; }
      w0.x = pk2(kd[0][0], kd[1][0]); w0.y = pk2(kd[2][0], kd[3][0]); w0.z = pk2(kd[4][0], kd[5][0]); w0.w = pk2(kd[6][0], kd[7][0]);
      w1.x = pk2(kd[0][1], kd[1][1]); w1.y = pk2(kd[2][1], kd[3][1]); w1.z = pk2(kd[4][1], kd[5][1]); w1.w = pk2(kd[6][1], kd[7][1]);
      *(LAS v4u*)(KB + (2 * cp) * TR_STRIDE + pg * 16) = w0; *(LAS v4u*)(KB + (2 * cp + 1) * TR_STRIDE + pg * 16) = w1; }
    __syncthreads();
    { const int dir = pg >> 2, tv0 = 2 * (pg & 3); const LAS unsigned char* KD = dir ? KB : KF;
      unsigned char* out = (unsigned char*)LT + (size_t)(dir ? seqb : seqf) * 16384;
      bf16x8 y0[2], y1[2];
#pragma unroll
      for (int ks = 0; ks < 2; ++ks) { y0[ks] = *(const LAS bf16x8*)(VT + (16 * tv0 + fr) * TR_STRIDE + (32 * ks + 8 * fq) * 2); y1[ks] = *(const LAS bf16x8*)(VT + (16 * tv0 + 16 + fr) * TR_STRIDE + (32 * ks + 8 * fq) * 2); }
#pragma unroll
      for (int tk = 0; tk < 8; ++tk) { f32x4 a0 = (f32x4){0.f, 0.f, 0.f, 0.f}, a1 = a0;
#pragma unroll
          for (int ks = 0; ks < 2; ++ks) { const bf16x8 x = *(const LAS bf16x8*)(KD + (16 * tk + fr) * TR_STRIDE + (32 * ks + 8 * fq) * 2); a0 = mfma16(x, y0[ks], a0); a1 = mfma16(x, y1[ks], a1); }
          *(unsigned*)(out + (size_t)(16 * tv0 + fr) * 128 + 16 * tk + 4 * fq) = pack_fp8x4(a0[0] * ST_SCALE, a0[1] * ST_SCALE, a0[2] * ST_SCALE, a0[3] * ST_SCALE);
          *(unsigned*)(out + (size_t)(16 * tv0 + 16 + fr) * 128 + 16 * tk + 4 * fq) = pack_fp8x4(a1[0] * ST_SCALE, a1[1] * ST_SCALE, a1[2] * ST_SCALE, a1[3] * ST_SCALE); } }
    __syncthreads();
}

__device__ __forceinline__ void hgrn_state_scan(bf16* LT, const float* DV, int T, int NT) {
    for (int x = T; x < 64 * 2048; x += NT) {
        const int seqi = x >> 11, e8 = x & 2047, dir = seqi >> 5, k0 = (e8 & 15) * 8;
        unsigned char* base = (unsigned char*)LT + (size_t)seqi * 128 * 16384 + e8 * 8; const float* dbase = DV + (size_t)seqi * 128 * 128 + k0;
        f32x4 S0 = (f32x4){0.f, 0.f, 0.f, 0.f}, S1 = S0;
        for (int cc = 0; cc < 128; cc += 8) {
            v2u L[8]; f32x4 d0[8], d1[8];
#pragma unroll
            for (int j = 0; j < 8; ++j) { const int c = dir ? (127 - cc - j) : (cc + j); L[j] = __builtin_nontemporal_load((const v2u*)(base + (size_t)c * 16384)); d0[j] = *(const f32x4*)(dbase + c * 128); d1[j] = *(const f32x4*)(dbase + c * 128 + 4); }
#pragma unroll
            for (int j = 0; j < 8; ++j) { const int c = dir ? (127 - cc - j) : (cc + j);
                *(v2u*)(base + (size_t)c * 16384) = (v2u){pack_fp8x4(S0[0], S0[1], S0[2], S0[3]), pack_fp8x4(S1[0], S1[1], S1[2], S1[3])};
                S0 = d0[j] * S0 + unpack_fp8x4(L[j].x); S1 = d1[j] * S1 + unpack_fp8x4(L[j].y); }
        }
    }
}

__device__ __forceinline__ bf16x8 frag_fp8(const LAS unsigned char* p) {
    const v2u w = *(const LAS v2u*)p; const f32x4 a = unpack_fp8x4(w.x), c = unpack_fp8x4(w.y);
    return __builtin_bit_cast(bf16x8, (v4u){pk2(a[0], a[1]), pk2(a[2], a[3]), pk2(c[0], c[1]), pk2(c[2], c[3])});
}
struct HoP { unsigned rq[8], rv[8], rkf[8], rkb[8]; };
__device__ __forceinline__ void hgrn_out_loadp(const bf16* proj, int it, int tid, HoP& P) {
    const int b = it >> 9, head = (it >> 7) & 3, c = it & 127, cp = tid & 63, pg = __builtin_amdgcn_readfirstlane(tid >> 6);
    const bf16* pq = proj + ((size_t)b * SEQ + c * 64 + pg * 8) * INC + 512 + head * 128 + 2 * cp;
#pragma unroll
    for (int i = 0; i < 8; ++i) { P.rq[i] = __builtin_nontemporal_load((const unsigned*)(pq + (size_t)i * INC)); P.rv[i] = __builtin_nontemporal_load((const unsigned*)(pq + (size_t)i * INC + 512));
        P.rkf[i] = __builtin_nontemporal_load((const unsigned*)(pq + (size_t)i * INC + 1024)); P.rkb[i] = __builtin_nontemporal_load((const unsigned*)(pq + (size_t)i * INC + 1536)); }
}
__device__ __forceinline__ void hgrn_out_item(const bf16* proj, const bf16* LT, const float* gnorm, bf16* ymix, LAS unsigned char* lds, int it, int tid, const HoP& R, int it_next, HoP& NX) {
    const int b = it >> 9, head = (it >> 7) & 3, c = it & 127;
    const int cp = tid & 63, pg = __builtin_amdgcn_readfirstlane(tid >> 6), lane = tid & 63, fr = lane & 15, fq = lane >> 4;
    LAS unsigned char* QTB = lds;
    LAS unsigned char* KTB = lds + 64 * CH_STRIDE;
    LAS unsigned char* VT = lds + 256 * CH_STRIDE;
    LAS unsigned char* PP = VT + 128 * TR_STRIDE;
    LAS unsigned char* S8 = PP + 64 * TR_STRIDE;
    LAS float* TF = (LAS float*)(S8 + 2 * 128 * TR_STRIDE);
    LAS float* TB = TF + 1024;
    LAS float* RS = TB + 1024;
    const int ti = pg & 3, hv = pg >> 2;
    v4u rawS[2][2];
#pragma unroll
    for (int dd = 0; dd < 2; ++dd) { const unsigned char* Sg = (const unsigned char*)LT + ((size_t)((dd * 32 + b * 4 + head) * 128 + c)) * 16384;
#pragma unroll
        for (int i = 0; i < 2; ++i) rawS[dd][i] = __builtin_nontemporal_load((const v4u*)(Sg + (size_t)(tid + 512 * i) * 16)); }
    v2u gzr[4];
    { const size_t rowg = (size_t)b * SEQ + c * 64 + 16 * ti + fr;
#pragma unroll
      for (int t = 0; t < 4; ++t) gzr[t] = __builtin_nontemporal_load((const v2u*)(proj + rowg * INC + 2560 + head * 128 + 64 * hv + 16 * t + 4 * fq)); }
    { float tf0 = 0.f, tf1 = 0.f, tb0 = 0.f, tb1 = 0.f;
#pragma unroll
      for (int i = 0; i < 8; ++i) { tf0 += fast_ln(1.0f - bflo(R.rkf[i])); tf1 += fast_ln(1.0f - bfhi(R.rkf[i])); tb0 += fast_ln(1.0f - bflo(R.rkb[i])); tb1 += fast_ln(1.0f - bfhi(R.rkb[i])); }
      *(LAS f32x2*)(TF + pg * 128 + 2 * cp) = (f32x2){tf0, tf1}; *(LAS f32x2*)(TB + pg * 128 + 2 * cp) = (f32x2){tb0, tb1};
      v4u w0, w1;
      w0.x = (R.rv[0] & 0xffffu) | (R.rv[1] << 16); w0.y = (R.rv[2] & 0xffffu) | (R.rv[3] << 16); w0.z = (R.rv[4] & 0xffffu) | (R.rv[5] << 16); w0.w = (R.rv[6] & 0xffffu) | (R.rv[7] << 16);
      w1.x = (R.rv[0] >> 16) | (R.rv[1] & 0xffff0000u); w1.y = (R.rv[2] >> 16) | (R.rv[3] & 0xffff0000u); w1.z = (R.rv[4] >> 16) | (R.rv[5] & 0xffff0000u); w1.w = (R.rv[6] >> 16) | (R.rv[7] & 0xffff0000u);
      *(LAS v4u*)(VT + (2 * cp) * TR_STRIDE + pg * 16) = w0; *(LAS v4u*)(VT + (2 * cp + 1) * TR_STRIDE + pg * 16) = w1; }
    __syncthreads();
    if (it_next < 4096) hgrn_out_loadp(proj, it_next, tid, NX);
#pragma unroll
    for (int dir = 0; dir < 2; ++dir) {
        const LAS float* TT = dir ? TB : TF; float o0 = 0.f, o1 = 0.f;
        LAS unsigned char* QT = QTB + dir * 128 * CH_STRIDE; LAS unsigned char* KT = KTB + dir * 128 * CH_STRIDE;
#pragma unroll
        for (int p = 0; p < 8; ++p) { const f32x2 a = *(const LAS f32x2*)(TT + p * 128 + 2 * cp); if (dir ? (p > pg) : (p < pg)) { o0 += a.x; o1 += a.y; } }
#pragma unroll
        for (int ii = 0; ii < 8; ++ii) { const int i = dir ? (7 - ii) : ii; const unsigned rk = dir ? R.rkb[i] : R.rkf[i];
            const float k0 = bflo(rk), k1 = bfhi(rk); o0 += fast_ln(1.0f - k0); o1 += fast_ln(1.0f - k1);
            const float e0 = __expf(o0), e1 = __expf(o1), n0 = __expf(-o0), n1 = __expf(-o1);
            *(LAS unsigned*)(QT + (8 * pg + i) * CH_STRIDE + 4 * cp) = pk2(bflo(R.rq[i]) * e0, bfhi(R.rq[i]) * e1);
            *(LAS unsigned*)(KT + (8 * pg + i) * CH_STRIDE + 4 * cp) = pk2(k0 * n0, k1 * n1); }
    }
#pragma unroll
    for (int dd = 0; dd < 2; ++dd)
#pragma unroll
        for (int i = 0; i < 2; ++i) { const int e = tid + 512 * i; *(LAS v4u*)(S8 + dd * 128 * TR_STRIDE + (e >> 3) * TR_STRIDE + (e & 7) * 16) = rawS[dd][i]; }
    __syncthreads();
    bf16x8 yq[2][4];
#pragma unroll
    for (int dir = 0; dir < 2; ++dir)
#pragma unroll
        for (int ks = 0; ks < 4; ++ks) yq[dir][ks] = *(const LAS bf16x8*)(QTB + dir * 128 * CH_STRIDE + (16 * ti + fr) * CH_STRIDE + (32 * ks + 8 * fq) * 2);
#pragma unroll
    for (int jj = 0; jj < 2; ++jj) { const int tj = 2 * hv + jj; f32x4 st = (f32x4){0.f, 0.f, 0.f, 0.f};
        const int ipos = 16 * ti + fr, j0 = 16 * tj + 4 * fq;
#pragma unroll
        for (int dir = 0; dir < 2; ++dir) {
            if (dir ? (tj >= ti) : (tj <= ti)) { f32x4 sd = (f32x4){0.f, 0.f, 0.f, 0.f};
#pragma unroll
                for (int ks = 0; ks < 4; ++ks) { const bf16x8 x = *(const LAS bf16x8*)(KTB + dir * 128 * CH_STRIDE + (16 * tj + fr) * CH_STRIDE + (32 * ks + 8 * fq) * 2); sd = mfma16(x, yq[dir][ks], sd); }
#pragma unroll
                for (int e = 0; e < 4; ++e) { const bool keep = dir ? (j0 + e >= ipos) : (j0 + e <= ipos); st[e] += keep ? sd[e] : 0.f; } } }
        *(LAS v2u*)(PP + (16 * ti + fr) * TR_STRIDE + (16 * tj + 4 * fq) * 2) = (v2u){pk2(st[0], st[1]), pk2(st[2], st[3])}; }
    __syncthreads();
    f32x4 acc[4], acci[4];
    { bf16x8 yp[2];
#pragma unroll
      for (int ks = 0; ks < 2; ++ks) yp[ks] = *(const LAS bf16x8*)(PP + (16 * ti + fr) * TR_STRIDE + (32 * ks + 8 * fq) * 2);
#pragma unroll
      for (int t = 0; t < 4; ++t) { const int tv = 4 * hv + t; acc[t] = (f32x4){0.f, 0.f, 0.f, 0.f}; acci[t] = acc[t];
#pragma unroll
          for (int ks = 0; ks < 2; ++ks) { const bf16x8 x = *(const LAS bf16x8*)(VT + (16 * tv + fr) * TR_STRIDE + (32 * ks + 8 * fq) * 2); acc[t] = mfma16(x, yp[ks], acc[t]); }
#pragma unroll
          for (int dir = 0; dir < 2; ++dir)
#pragma unroll
              for (int ks = 0; ks < 4; ++ks) { const bf16x8 x = frag_fp8(S8 + dir * 128 * TR_STRIDE + (16 * tv + fr) * TR_STRIDE + 32 * ks + 8 * fq); acci[t] = mfma16(x, yq[dir][ks], acci[t]); }
          acc[t] = acc[t] + acci[t] * ST_INV; } }
    float ss = 0.f;
#pragma unroll
    for (int t = 0; t < 4; ++t) ss += (acc[t][0] * acc[t][0] + acc[t][1] * acc[t][1]) + (acc[t][2] * acc[t][2] + acc[t][3] * acc[t][3]);
    ss += __shfl_xor(ss, 16); ss += __shfl_xor(ss, 32);
    if (fq == 0) RS[hv * 64 + 16 * ti + fr] = ss;
    __syncthreads();
    const float r = __builtin_amdgcn_rsqf((RS[16 * ti + fr] + RS[64 + 16 * ti + fr]) * (1.0f / 128.0f) + EPS);
    const size_t row = (size_t)b * SEQ + c * 64 + 16 * ti + fr;
#pragma unroll
    for (int t = 0; t < 4; ++t) { const int vcol = 64 * hv + 16 * t + 4 * fq; const f32x4 gn = *(const f32x4*)(gnorm + vcol);
        const v2u gz = gzr[t];
        *(v2u*)(ymix + row * D + 512 + head * 128 + vcol) = (v2u){pk2(acc[t][0] * r * gn[0] * bflo(gz.x), acc[t][1] * r * gn[1] * bfhi(gz.x)), pk2(acc[t][2] * r * gn[2] * bflo(gz.y), acc[t][3] * r * gn[3] * bfhi(gz.y))}; }
}

__device__ __forceinline__ void final_norm(const bf16* hb, float* out, const float* ssq3, const float* wf, int gw, int NGW, int lane) {
    f32x4 w4[4];
#pragma unroll
    for (int j = 0; j < 2; ++j) { w4[2 * j] = *(const f32x4*)(wf + 512 * j + lane * 8); w4[2 * j + 1] = *(const f32x4*)(wf + 512 * j + lane * 8 + 4); }
    for (int m = gw; m < M; m += NGW) {
        const float r = __builtin_amdgcn_rsqf(ssq3[m] * (1.0f / 1024.0f) + EPS);
        const v4u h0 = __builtin_nontemporal_load((const v4u*)(hb + (size_t)m * D + lane * 8)), h1 = __builtin_nontemporal_load((const v4u*)(hb + (size_t)m * D + 512 + lane * 8));
        float* o = out + (size_t)m * D + lane * 8;
        __builtin_nontemporal_store((f32x4){bflo(h0.x), bfhi(h0.x), bflo(h0.y), bfhi(h0.y)} * r * w4[0], (f32x4*)(o));
        __builtin_nontemporal_store((f32x4){bflo(h0.z), bfhi(h0.z), bflo(h0.w), bfhi(h0.w)} * r * w4[1], (f32x4*)(o + 4));
        __builtin_nontemporal_store((f32x4){bflo(h1.x), bfhi(h1.x), bflo(h1.y), bfhi(h1.y)} * r * w4[2], (f32x4*)(o + 512));
        __builtin_nontemporal_store((f32x4){bflo(h1.z), bfhi(h1.z), bflo(h1.w), bfhi(h1.w)} * r * w4[3], (f32x4*)(o + 516));
    }
}

__global__ void __launch_bounds__(NWAVES * 64, 2) mk_fwd(Args args) {
    extern __shared__ __attribute__((aligned(16))) unsigned char lds_raw[];
    cg::grid_group grid = cg::this_grid();
    LAS unsigned char* lds = (LAS unsigned char*)lds_raw;
    const int tid = threadIdx.x, lane = tid & 63, wave = __builtin_amdgcn_readfirstlane(tid >> 6);
    const int G = gridDim.x, bx = blockIdx.x;
    const int vcu = (G % 8 == 0) ? (bx % 8) * (G / 8) + bx / 8 : bx;
    const int gw = vcu * NWAVES + wave, NGW = G * NWAVES;
    unsigned char* ws = args.ws;
    float* ssq = (float*)(ws + WS_SSQ);
    bf16* actb = (bf16*)(ws + WS_ACTB); bf16* ymix = (bf16*)(ws + WS_YMIX); bf16* proj = (bf16*)(ws + WS_PROJ); bf16* hid = (bf16*)(ws + WS_PROJ);
    bf16* LT = (bf16*)(ws + WS_LT); float* DV = args.out; bf16* pooled = (bf16*)(ws + WS_POOLED);

    volatile LAS unsigned* MISC = (volatile LAS unsigned*)(lds + 143360);
    if (tid < 32) MISC[tid] = 0u;
    __syncthreads();
    const XcdBarrier bar = xcd_barrier_post((unsigned*)(ws + WS_BAR), MISC + 8);
    p0_prologue(args, lds, gw, NGW, wave, lane);
    if (args.ws == nullptr) grid.sync();
    xcd_barrier(bar);
    { pg8::Gemm g{actb, (const bf16*)(ws + WS_WGU1), M, 2 * FF, D}; pg8::StaticOrder S; S.init(M, 2 * FF, G, bx);
      pg8::EpiSwiglu E{hid, FF, ssq};
      pg8::gemm_phase<pg8::EpiSwiglu, pg8::StaticOrder, true, true>(lds, g, S, E); }
    xcd_barrier(bar);
    { pg8::Gemm g{hid, (const bf16*)(ws + WS_WD1), M, D, FF}; pg8::StaticOrder S; S.init(M, D, G, bx, 1);
      pg8::EpiResid E{actb, ssq + M, 0.5f, D};
      pg8::gemm_phase<pg8::EpiResid, pg8::StaticOrder, true, true>(lds, g, S, E); }
    xcd_barrier(bar);
    { pg8::Gemm g{actb, (const bf16*)(ws + WS_WIN), M, INC, D}; pg8::StaticOrder S; S.init(M, INC, G, bx);
      pg8::EpiProj E{proj, INC, ssq + M, (const float*)(ws + WS_OMLB)};
      pg8::gemm_phase<pg8::EpiProj, pg8::StaticOrder, true, true>(lds, g, S, E); }
    xcd_barrier(bar);
    pool_rows(proj, ymix, gw, NGW, lane);
    { HlP LA, LB; int it = bx;
      if (it < 4096) hgrn_local_loadp(proj, it, tid, LA);
      for (; it < 4096; it += 2 * G) {
          hgrn_local_item(proj, LT, DV, lds, it, tid, LA, (it + G < 4096) ? it + G : -1, LB);
          if (it + G < 4096) hgrn_local_item(proj, LT, DV, lds, it + G, tid, LB, (it + 2 * G < 4096) ? it + 2 * G : -1, LA); } }
    xcd_barrier(bar);
    hgrn_state_scan(LT, DV, bx * (NWAVES * 64) + tid, G * NWAVES * 64);
    xcd_barrier(bar);
    { HoP PA, PB; int it = bx;
      if (it < 4096) hgrn_out_loadp(proj, it, tid, PA);
      for (; it < 4096; it += 2 * G) {
          hgrn_out_item(proj, LT, args.in[10], ymix, lds, it, tid, PA, it + G, PB);
          if (it + G < 4096) hgrn_out_item(proj, LT, args.in[10], ymix, lds, it + G, tid, PB, it + 2 * G, PA); } }
    xcd_barrier(bar);
    { pg8::Gemm g{ymix, (const bf16*)(ws + WS_WOUT), M, D, D}; pg8::StaticOrder S; S.init(M, D, G, bx);
      pg8::EpiResid E{actb, ssq + 2 * M, 1.0f, D};
      pg8::gemm_phase<pg8::EpiResid, pg8::StaticOrder, true, true>(lds, g, S, E); }
    xcd_barrier(bar);
    { pg8::Gemm g{actb, (const bf16*)(ws + WS_WGU2), M, 2 * FF, D}; pg8::StaticOrder S; S.init(M, 2 * FF, G, bx);
      pg8::EpiSwiglu E{hid, FF, ssq + 2 * M};
      pg8::gemm_phase<pg8::EpiSwiglu, pg8::StaticOrder, true, true>(lds, g, S, E); }
    xcd_barrier(bar);
    { pg8::Gemm g{hid, (const bf16*)(ws + WS_WD2), M, D, FF}; pg8::StaticOrder S; S.init(M, D, G, bx, 1);
      pg8::EpiResid E{actb, ssq + 3 * M, 0.5f, D};
      pg8::gemm_phase<pg8::EpiResid, pg8::StaticOrder, true, true>(lds, g, S, E); }
    xcd_barrier(bar);
    final_norm(actb, args.out, ssq + 3 * M, args.in[16], gw, NGW, lane);
}

extern "C" void kernel_launch(void* const* d_in, const int* in_sizes, int n_in, void* d_out, int out_size, void* d_ws, size_t ws_size, hipStream_t stream) {
    static int grid = 0;
    if (grid == 0) {
        if (n_in != 17 || in_sizes[0] != M * D || out_size != M * D || ws_size < WS_END) { fprintf(stderr, "kernel_launch: unexpected shapes: n_in %d in0 %d out %d ws %zu\n", n_in, n_in > 0 ? in_sizes[0] : -1, out_size, ws_size); grid = -1; return; }
        int dev = 0, cus = 0, per_cu = 0;
        if (hipGetDevice(&dev) != hipSuccess || hipDeviceGetAttribute(&cus, hipDeviceAttributeMultiprocessorCount, dev) != hipSuccess) { grid = -1; return; }
        if (hipFuncSetAttribute((const void*)mk_fwd, hipFuncAttributeMaxDynamicSharedMemorySize, LDS_BYTES) != hipSuccess) { fprintf(stderr, "kernel_launch: hipFuncSetAttribute failed\n"); grid = -1; return; }
        if (hipOccupancyMaxActiveBlocksPerMultiprocessor(&per_cu, (const void*)mk_fwd, NWAVES * 64, LDS_BYTES) != hipSuccess || per_cu < 1) { fprintf(stderr, "kernel_launch: occupancy query says %d\n", per_cu); per_cu = 1; }
        (void)hipGetLastError();
        grid = cus * 1;
    }
    if (grid < 0) return;
    if (hipMemsetAsync((char*)d_ws + WS_BAR, 0, 16384, stream) != hipSuccess) { fprintf(stderr, "kernel_launch: memset of barrier words failed\n"); return; }
    Args a{};
    for (int i = 0; i < 17; ++i) a.in[i] = (const float*)d_in[i];
    a.out = (float*)d_out; a.ws = (unsigned char*)d_ws;
    void* kargs[] = {&a};
    hipError_t e = hipLaunchCooperativeKernel((const void*)mk_fwd, dim3(grid), dim3(NWAVES * 64), kargs, LDS_BYTES, stream);
    if (e != hipSuccess) fprintf(stderr, "kernel_launch: cooperative launch failed: %s (grid %d)\n", hipGetErrorString(e), grid);
}
```

```cpp
#include <hip/hip_runtime.h>
#include <hip/hip_cooperative_groups.h>
#include <cstdio>
#include <cstdint>
namespace cg = cooperative_groups;
namespace pg8 {
#define PG8_LAS __attribute__((address_space(3)))
typedef unsigned short bf16_t;
typedef short bf16x8 __attribute__((ext_vector_type(8)));
typedef float f32x4 __attribute__((ext_vector_type(4)));
typedef unsigned u32x4 __attribute__((ext_vector_type(4)));
constexpr int BM = 256, BK = 64, HALF = 128, HTB = HALF * BK * 2  , STAGE_BYTES = 8 * HTB, NXCD = 8, WGM = 8;

__host__ __device__ __forceinline__ int lds_byte(int r, int c) { const int st = (r >> 4) * 2 + (c >> 5), rr = r & 15, cc = c & 31, ob = rr * 64 + cc * 2; return st * 1024 + (ob ^ (((ob >> 9) & 1) << 5)); }
__host__ __device__ __forceinline__ void stage_rc(int b, int& R, int& C) { const int st = b / 1024, sb = b % 1024, swz = sb ^ (((sb >> 9) & 1) << 5); R = (st >> 1) * 16 + swz / 64; C = (st & 1) * 32 + (swz % 64) / 2; }
__host__ __device__ __forceinline__ int perm32(int rho) { const int n = rho >> 4, i = rho & 15; return 8 * (i >> 2) + 4 * n + (i & 3); }

struct Unit { int pm, pn; };
struct Gemm { const bf16_t* A; const bf16_t* Bt; int M, N, K; };

struct StaticOrder {
    int nM, nN, nwg, G, c, rev;
    __host__ __device__ void init(int M, int N, int G_, int c_, int rev_ = 0) { nM = M / BM; nN = N / BM; nwg = nM * nN; G = G_; c = c_; rev = rev_; }
    __host__ __device__ bool next(int i, Unit& u) const {
        const long L = (long)i * G + c; if (L >= nwg) return false;
        int wgid = (int)L; { const int q = nwg / NXCD, r = nwg % NXCD, xcd = wgid % NXCD; int off = wgid / NXCD; if (rev && r == 0) off = q - 1 - off; wgid = (xcd < r ? xcd * (q + 1) : r * (q + 1) + (xcd - r) * q) + off; }
        const int nig = WGM * nN, gid = wgid / nig, fm = gid * WGM, gsz = (nM - fm) < WGM ? (nM - fm) : WGM;
        u.pm = fm + ((wgid % nig) % gsz); u.pn = (wgid % nig) / gsz; return true;
    }
    __device__ __forceinline__ void a_ready(const Unit&) const {}
    __device__ __forceinline__ void done(const Unit&) const {}
};
typedef float f32x2 __attribute__((ext_vector_type(2)));
typedef __bf16 bf16x2_t __attribute__((ext_vector_type(2)));
__device__ __forceinline__ unsigned cvt_pk_bf16(float lo, float hi) { f32x2 v = {lo, hi}; bf16x2_t b = __builtin_convertvector(v, bf16x2_t); return __builtin_bit_cast(unsigned, b); }

constexpr float RMS_EPS = 1e-6f;
__device__ __forceinline__ float fast_sigmoid(float v) { return __builtin_amdgcn_rcpf(1.0f + __expf(-v)); }
__device__ __forceinline__ float silu_f(float v) { return v * fast_sigmoid(v); }

struct EpiSwiglu {
    static constexpr bool PERM = true, AFTER_DRAIN = false;
    bf16_t* O; int ldc; const float* ssq;
    __device__ __forceinline__ void operator()(const f32x4 (&acc)[2][2][4][2], const Unit& u, int wr, int wc, int fr, int fq) const {
        const int row0 = u.pm * BM + wr * 64 + fr, col0 = u.pn * HALF + wc * 32 + 8 * fq;
#pragma unroll
        for (int ai = 0; ai < 2; ++ai)
#pragma unroll
            for (int m = 0; m < 4; ++m) { const int row = row0 + ai * HALF + m * 16;
                const float r = __builtin_amdgcn_rsqf(ssq[row] * (1.0f / 1024.0f) + RMS_EPS);
                float h[8];
#pragma unroll
                for (int n = 0; n < 2; ++n)
#pragma unroll
                    for (int e = 0; e < 4; ++e) { const float g = acc[ai][0][m][n][e] * r, up = acc[ai][1][m][n][e] * r; h[4 * n + e] = silu_f(g) * up; }
                u32x4 w; w.x = cvt_pk_bf16(h[0], h[1]); w.y = cvt_pk_bf16(h[2], h[3]); w.z = cvt_pk_bf16(h[4], h[5]); w.w = cvt_pk_bf16(h[6], h[7]);
                *(u32x4*)(O + (size_t)row * ldc + col0) = w; }
    }
};
struct EpiResid {
    static constexpr bool PERM = true, AFTER_DRAIN = false;
    bf16_t* hb; float* ssq_out; float scale; int ldc;
    __device__ __forceinline__ void operator()(const f32x4 (&acc)[2][2][4][2], const Unit& u, int wr, int wc, int fr, int fq) const {
        const int row0 = u.pm * BM + wr * 64 + fr, col0 = u.pn * BM + wc * 32 + 8 * fq;
#pragma unroll
        for (int ai = 0; ai < 2; ++ai)
#pragma unroll
            for (int m = 0; m < 4; ++m) { const int row = row0 + ai * HALF + m * 16; const size_t off = (size_t)row * ldc + col0; float s = 0.f;
                u32x4 bw[2];
#pragma unroll
                for (int bj = 0; bj < 2; ++bj) bw[bj] = *(const u32x4*)(hb + off + bj * HALF);
#pragma unroll
                for (int bj = 0; bj < 2; ++bj) {
                    const f32x4 b0 = (f32x4){__uint_as_float(bw[bj].x << 16), __uint_as_float(bw[bj].x & 0xffff0000u), __uint_as_float(bw[bj].y << 16), __uint_as_float(bw[bj].y & 0xffff0000u)};
                    const f32x4 b1 = (f32x4){__uint_as_float(bw[bj].z << 16), __uint_as_float(bw[bj].z & 0xffff0000u), __uint_as_float(bw[bj].w << 16), __uint_as_float(bw[bj].w & 0xffff0000u)};
                    const f32x4 v0 = b0 + acc[ai][bj][m][0] * scale, v1 = b1 + acc[ai][bj][m][1] * scale;
                    u32x4 w; w.x = cvt_pk_bf16(v0[0], v0[1]); w.y = cvt_pk_bf16(v0[2], v0[3]); w.z = cvt_pk_bf16(v1[0], v1[1]); w.w = cvt_pk_bf16(v1[2], v1[3]);
                    *(u32x4*)(hb + off + bj * HALF) = w;
                    s += (v0[0] * v0[0] + v0[1] * v0[1]) + (v0[2] * v0[2] + v0[3] * v0[3]) + (v1[0] * v1[0] + v1[1] * v1[1]) + (v1[2] * v1[2] + v1[3] * v1[3]); }
                s += __shfl_xor(s, 16); s += __shfl_xor(s, 32);
                if (fq == 0) unsafeAtomicAdd(ssq_out + row, s); }
    }
};
struct EpiProj {
    static constexpr bool PERM = true, AFTER_DRAIN = false;
    bf16_t* O; int ldc; const float* ssq; const float* omlb;
    __device__ __forceinline__ void operator()(const f32x4 (&acc)[2][2][4][2], const Unit& u, int wr, int wc, int fr, int fq) const {
        const int row0 = u.pm * BM + wr * 64 + fr, col0 = u.pn * BM + wc * 32 + 8 * fq; const int type = u.pn >> 1;
        float ol[2][8];
#pragma unroll
        for (int bj = 0; bj < 2; ++bj)
#pragma unroll
            for (int e = 0; e < 8; ++e) ol[bj][e] = (type == 3 || type == 4) ? omlb[col0 + bj * HALF + e - 1536] : 0.f;
#pragma unroll
        for (int ai = 0; ai < 2; ++ai)
#pragma unroll
            for (int m = 0; m < 4; ++m) { const int row = row0 + ai * HALF + m * 16;
                const float r = __builtin_amdgcn_rsqf(ssq[row] * (1.0f / 1024.0f) + RMS_EPS);
#pragma unroll
                for (int bj = 0; bj < 2; ++bj) { float h[8];
#pragma unroll
                    for (int n = 0; n < 2; ++n)
#pragma unroll
                        for (int e = 0; e < 4; ++e) { const float v = acc[ai][bj][m][n][e] * r; float o = v;
                            if (type == 1 || type == 5) o = silu_f(v);
                            if (type == 3 || type == 4) o = ol[bj][4 * n + e] * __builtin_amdgcn_rcpf(1.0f + __expf(v));
                            h[4 * n + e] = o; }
                    u32x4 w; w.x = cvt_pk_bf16(h[0], h[1]); w.y = cvt_pk_bf16(h[2], h[3]); w.z = cvt_pk_bf16(h[4], h[5]); w.w = cvt_pk_bf16(h[6], h[7]);
                    u32x4* dst = (u32x4*)(O + (size_t)row * ldc + col0 + bj * HALF);
                    if (type == 1 || type == 5) __builtin_nontemporal_store(w, dst); else *dst = w; } }
    }
};
struct EpiPlain {
    static constexpr bool PERM = true, AFTER_DRAIN = false;
    bf16_t* O; int ldc;
    __device__ __forceinline__ void operator()(const f32x4 (&acc)[2][2][4][2], const Unit& u, int wr, int wc, int fr, int fq) const {
        const int row0 = u.pm * BM + wr * 64 + fr, col0 = u.pn * BM + wc * 32 + 8 * fq;
#pragma unroll
        for (int ai = 0; ai < 2; ++ai)
#pragma unroll
            for (int m = 0; m < 4; ++m) { const int row = row0 + ai * HALF + m * 16;
#pragma unroll
                for (int bj = 0; bj < 2; ++bj) { const f32x4 v0 = acc[ai][bj][m][0], v1 = acc[ai][bj][m][1];
                    u32x4 w; w.x = cvt_pk_bf16(v0[0], v0[1]); w.y = cvt_pk_bf16(v0[2], v0[3]); w.z = cvt_pk_bf16(v1[0], v1[1]); w.w = cvt_pk_bf16(v1[2], v1[3]);
                    *(u32x4*)(O + (size_t)row * ldc + col0 + bj * HALF) = w; } }
    }
};

template <class Epi, class Sched, bool ALIGN_EPI = false, bool SP2 = false>
__device__ __forceinline__ void gemm_phase(PG8_LAS unsigned char* lds, const Gemm g, const Sched& S, const Epi& E) {
    const int tid = threadIdx.x, wid = __builtin_amdgcn_readfirstlane(tid >> 6), lane = tid & 63, wr = wid >> 2, wc = wid & 3, fr = lane & 15, fq = lane >> 4;
    const int K = g.K, nt = K / BK;
    unsigned voffA[2], voffB[2];
#pragma unroll
    for (int i = 0; i < 2; ++i) { int R, C; stage_rc(tid * 16 + i * 8192, R, C); const int Rb = Epi::PERM ? ((R & ~31) + perm32(R & 31)) : R;
        voffA[i] = (unsigned)(R * K + C) * 2u; voffB[i] = (unsigned)(Rb * K + C) * 2u; }
    const size_t kstep = (size_t)(BK * 2);
    const size_t hstep = (size_t)HALF * K * 2;
    const size_t tstep = 2 * hstep;
    const unsigned ldsw = (unsigned)wid * 1024u;
    const int aoff = lds_byte(wr * 64 + fr, fq * 8), boff = lds_byte(wc * 32 + fr, fq * 8);
#define PG8_SA(b, h) (((b) * 2 + (h)) * HTB)
#define PG8_SB(b, h) ((4 + (b) * 2 + (h)) * HTB)
#define PG8_STAGE(bufoff, gbase, voff) do { _Pragma("unroll") for (int _i = 0; _i < 2; ++_i) \
        __builtin_amdgcn_global_load_lds((const unsigned*)((const char*)(gbase) + (voff)[_i]), (PG8_LAS unsigned*)(lds + (bufoff) + ldsw + _i * 8192), 16, 0, 0); } while (0)
#define PG8_LDA(dst, b, h) do { _Pragma("unroll") for (int m = 0; m < 4; ++m) _Pragma("unroll") for (int k = 0; k < 2; ++k) dst[m][k] = *(const PG8_LAS bf16x8*)(lds + PG8_SA(b, h) + aoff + m * 2048 + k * 1024); } while (0)
#define PG8_LDB(dst, b, h) do { _Pragma("unroll") for (int n = 0; n < 2; ++n) _Pragma("unroll") for (int k = 0; k < 2; ++k) dst[n][k] = *(const PG8_LAS bf16x8*)(lds + PG8_SB(b, h) + boff + n * 2048 + k * 1024); } while (0)
#define PG8_MMA(ai, bj, At, Bt) do { __builtin_amdgcn_s_setprio(1); _Pragma("unroll") for (int m = 0; m < 4; ++m) _Pragma("unroll") for (int n = 0; n < 2; ++n) _Pragma("unroll") for (int k = 0; k < 2; ++k) \
        acc[ai][bj][m][n] = __builtin_amdgcn_mfma_f32_16x16x32_bf16(Bt[n][k], At[m][k], acc[ai][bj][m][n], 0, 0, 0); __builtin_amdgcn_s_setprio(0); } while (0)
#define PG8_WAIT_V(n) asm volatile("s_waitcnt vmcnt(" #n ")" ::: "memory")
#define PG8_WAIT_L(n) asm volatile("s_waitcnt lgkmcnt(" #n ")" ::: "memory")
#define PG8_BAR __builtin_amdgcn_s_barrier()
#define PG8_SCHED __builtin_amdgcn_sched_barrier(0)
    Unit cur, nxt; int ui = 0;
    if (!S.next(0, cur)) return;
    f32x4 acc[2][2][4][2];
#pragma unroll
    for (int a = 0; a < 2; ++a)
#pragma unroll
        for (int b = 0; b < 2; ++b)
#pragma unroll
            for (int m = 0; m < 4; ++m)
#pragma unroll
                for (int n = 0; n < 2; ++n) acc[a][b][m][n] = (f32x4){0.f, 0.f, 0.f, 0.f};
    bf16x8 At[4][2], B0[2][2], B1[2][2];
    const char* cA = (const char*)g.A + (size_t)cur.pm * tstep; const char* cB = (const char*)g.Bt + (size_t)cur.pn * tstep;
    S.a_ready(cur);
    if constexpr (SP2) {
        PG8_STAGE(PG8_SB(0, 0), cB, voffB); PG8_STAGE(PG8_SB(0, 1), cB + hstep, voffB); PG8_STAGE(PG8_SA(0, 0), cA, voffA); PG8_STAGE(PG8_SA(0, 1), cA + hstep, voffA);
        if (wr == 1) PG8_BAR;
        PG8_WAIT_V(2); PG8_BAR;
        PG8_STAGE(PG8_SB(1, 0), cB + kstep, voffB); PG8_STAGE(PG8_SA(1, 0), cA + kstep, voffA); PG8_STAGE(PG8_SB(1, 1), cB + hstep + kstep, voffB);
        PG8_WAIT_V(6); PG8_BAR;
    } else {
        PG8_STAGE(PG8_SB(0, 0), cB, voffB); PG8_STAGE(PG8_SA(0, 0), cA, voffA); PG8_STAGE(PG8_SB(0, 1), cB + hstep, voffB); PG8_STAGE(PG8_SA(0, 1), cA + hstep, voffA);
        if (wr == 1) PG8_BAR;
        PG8_WAIT_V(4); PG8_BAR;
        PG8_STAGE(PG8_SB(1, 0), cB + kstep, voffB); PG8_STAGE(PG8_SA(1, 0), cA + kstep, voffA); PG8_STAGE(PG8_SB(1, 1), cB + hstep + kstep, voffB);
        PG8_WAIT_V(6); PG8_BAR;
    }
    for (;;) {
        const bool has_next = S.next(ui + 1, nxt);
        const char* nA = has_next ? (const char*)g.A + (size_t)nxt.pm * tstep : cA; const char* nB = has_next ? (const char*)g.Bt + (size_t)nxt.pn * tstep : cB;
        for (int t = 0; t < nt; t += 2) {
            const bool last = (t == nt - 2);
            const char* a1 = cA + (size_t)(t + 1) * kstep;
            const char* a2 = last ? nA : cA + (size_t)(t + 2) * kstep; const char* b2 = last ? nB : cB + (size_t)(t + 2) * kstep;
            const char* a3 = a2 + kstep; const char* b3 = b2 + kstep;
            if (last && has_next) S.a_ready(nxt);
            if constexpr (SP2) {
            PG8_LDB(B0, 0, 0); PG8_LDB(B1, 0, 1); PG8_SCHED; PG8_LDA(At, 0, 0); PG8_STAGE(PG8_SA(1, 1), a1 + hstep, voffA);
            PG8_WAIT_V(8); PG8_WAIT_L(0); PG8_BAR; PG8_MMA(0, 0, At, B0); PG8_MMA(0, 1, At, B1); PG8_BAR; PG8_SCHED;
            PG8_LDA(At, 0, 1); PG8_STAGE(PG8_SB(0, 0), b2, voffB); PG8_STAGE(PG8_SB(0, 1), b2 + hstep, voffB); PG8_STAGE(PG8_SA(0, 0), a2, voffA);
            PG8_WAIT_V(8); PG8_WAIT_L(0); PG8_BAR; PG8_MMA(1, 0, At, B0); PG8_MMA(1, 1, At, B1); PG8_BAR; PG8_SCHED;
            PG8_LDB(B0, 1, 0); PG8_LDB(B1, 1, 1); PG8_SCHED; PG8_LDA(At, 1, 0); PG8_STAGE(PG8_SA(0, 1), a2 + hstep, voffA);
            PG8_WAIT_V(8); PG8_WAIT_L(0); PG8_BAR; PG8_MMA(0, 0, At, B0); PG8_MMA(0, 1, At, B1); PG8_BAR; PG8_SCHED;
            PG8_LDA(At, 1, 1); PG8_STAGE(PG8_SB(1, 0), b3, voffB); PG8_STAGE(PG8_SB(1, 1), b3 + hstep, voffB); PG8_STAGE(PG8_SA(1, 0), a3, voffA);
            PG8_WAIT_V(8); PG8_WAIT_L(0); PG8_BAR; PG8_MMA(1, 0, At, B0); PG8_MMA(1, 1, At, B1); PG8_BAR; PG8_SCHED;
            } else {
            PG8_LDB(B0, 0, 0); PG8_SCHED; PG8_LDA(At, 0, 0); PG8_STAGE(PG8_SA(1, 1), a1 + hstep, voffA);
            PG8_WAIT_L(8); PG8_BAR; PG8_WAIT_L(0); PG8_MMA(0, 0, At, B0); PG8_BAR; PG8_SCHED;
            PG8_LDB(B1, 0, 1); PG8_STAGE(PG8_SB(0, 0), b2, voffB);
            PG8_BAR; PG8_WAIT_L(0); PG8_MMA(0, 1, At, B1); PG8_BAR;
            PG8_LDA(At, 0, 1); PG8_STAGE(PG8_SA(0, 0), a2, voffA);
            PG8_BAR; PG8_WAIT_L(0); PG8_MMA(1, 0, At, B0); PG8_BAR; PG8_SCHED;
            PG8_STAGE(PG8_SB(0, 1), b2 + hstep, voffB);
            PG8_WAIT_V(6); PG8_BAR; PG8_MMA(1, 1, At, B1); PG8_BAR;
            PG8_LDB(B0, 1, 0); PG8_SCHED; PG8_LDA(At, 1, 0); PG8_STAGE(PG8_SA(0, 1), a2 + hstep, voffA);
            PG8_WAIT_L(8); PG8_BAR; PG8_WAIT_L(0); PG8_MMA(0, 0, At, B0); PG8_BAR; PG8_SCHED;
            PG8_LDB(B1, 1, 1); PG8_STAGE(PG8_SB(1, 0), b3, voffB);
            PG8_BAR; PG8_WAIT_L(0); PG8_MMA(0, 1, At, B1); PG8_BAR;
            PG8_LDA(At, 1, 1); PG8_STAGE(PG8_SA(1, 0), a3, voffA);
            PG8_BAR; PG8_WAIT_L(0); PG8_MMA(1, 0, At, B0); PG8_BAR; PG8_SCHED;
            PG8_STAGE(PG8_SB(1, 1), b3 + hstep, voffB);
            PG8_WAIT_V(6); PG8_BAR; PG8_MMA(1, 1, At, B1); PG8_BAR;
            }
        }
        if constexpr (ALIGN_EPI) { if (wr == 0) PG8_BAR; }
        if constexpr (!Epi::AFTER_DRAIN) { E(acc, cur, wr, wc, fr, fq); S.done(cur); }
        if (!has_next) break;
#pragma unroll
        for (int a = 0; a < 2; ++a)
#pragma unroll
            for (int b = 0; b < 2; ++b)
#pragma unroll
                for (int m = 0; m < 4; ++m)
#pragma unroll
                    for (int n = 0; n < 2; ++n) acc[a][b][m][n] = (f32x4){0.f, 0.f, 0.f, 0.f};
        cur = nxt; cA = nA; cB = nB; ++ui;
        if constexpr (ALIGN_EPI) { if (wr == 1) PG8_BAR; }
    }
    PG8_WAIT_V(0);
    if constexpr (!ALIGN_EPI) { if (wr == 0) PG8_BAR; }
    PG8_BAR;
    if constexpr (Epi::AFTER_DRAIN) { E.fused(acc, cur, wr, wc, fr, fq, lds, wid, lane); S.done(cur); }
#undef PG8_SA
#undef PG8_SB
#undef PG8_STAGE
#undef PG8_LDA
#undef PG8_LDB
#undef PG8_MMA
#undef PG8_WAIT_V
#undef PG8_WAIT_L
#undef PG8_BAR
#undef PG8_SCHED
}
}

constexpr int NWAVES = 8;
constexpr int BATCH = 8, SEQ = 8192, D = 1024, FF = 2816, INC = 3072, PW = 512, HW = 512, HD = 128;
constexpr int M = BATCH * SEQ;
constexpr float EPS = 1e-6f;
constexpr size_t MiB = 1u << 20;
constexpr size_t WS_SSQ = 0;
constexpr size_t WS_BAR = 1 * MiB + 512 * 1024;
constexpr size_t WS_OMLB = 1 * MiB;
constexpr size_t WS_WGU1 = 2 * MiB;
constexpr size_t WS_WD1 = 13 * MiB;
constexpr size_t WS_WIN = 19 * MiB;
constexpr size_t WS_WOUT = 25 * MiB;
constexpr size_t WS_WGU2 = 27 * MiB;
constexpr size_t WS_WD2 = 38 * MiB;
constexpr size_t WS_WPOOL = 44 * MiB;
constexpr size_t WS_ACTB = 48 * MiB;
constexpr size_t WS_YMIX = 176 * MiB;
constexpr size_t WS_PROJ = 304 * MiB;
constexpr size_t WS_LT = 688 * MiB;
constexpr size_t WS_POOLED = 944 * MiB;
constexpr size_t WS_END = 1008 * MiB;
constexpr int LDS_BYTES = 147456;

#define LAS __attribute__((address_space(3)))
typedef unsigned short bf16;
typedef unsigned v4u __attribute__((ext_vector_type(4)));
typedef unsigned v2u __attribute__((ext_vector_type(2)));
typedef float f32x4 __attribute__((ext_vector_type(4)));
typedef float f32x2 __attribute__((ext_vector_type(2)));
#define LDS_WAIT() asm volatile("s_waitcnt lgkmcnt(0)" ::: "memory")
__device__ __forceinline__ unsigned pk2(float lo, float hi) { return pg8::cvt_pk_bf16(lo, hi); }
__device__ __forceinline__ float bflo(unsigned w) { return __uint_as_float(w << 16); }
__device__ __forceinline__ float bfhi(unsigned w) { return __uint_as_float(w & 0xffff0000u); }
__device__ __forceinline__ float wave_sum(float v) {
#pragma unroll
    for (int o = 1; o < 64; o <<= 1) v += __shfl_xor(v, o);
    return v;
}

__device__ __forceinline__ void transpose_item(const float* W, int N, bf16* WT, int ldk, int koff, int mode, int rowoff, const float* ks, const float* ns, LAS float* scr, int item, int lane) {
    const int nblk = N / 32, kb = item / nblk, nb = item % nblk, k0 = 64 * kb, n0 = 32 * nb;
#pragma unroll
    for (int i = 0; i < 32; ++i) { const int kk = 2 * i + (lane >> 5); float w = __builtin_nontemporal_load(W + (size_t)(k0 + kk) * N + n0 + (lane & 31)); if (ks) w *= ks[k0 + kk]; scr[kk * 33 + (lane & 31)] = w; }
    LDS_WAIT(); asm volatile("" ::: "memory");
    const int c = lane & 7;
#pragma unroll
    for (int j = 0; j < 4; ++j) { const int n = (lane >> 3) + 8 * j; const LAS float* s = scr + (8 * c) * 33 + n; const float sc = ns ? ns[n0 + n] : 1.0f;
        v4u o; o.x = pk2(s[0 * 33] * sc, s[1 * 33] * sc); o.y = pk2(s[2 * 33] * sc, s[3 * 33] * sc); o.z = pk2(s[4 * 33] * sc, s[5 * 33] * sc); o.w = pk2(s[6 * 33] * sc, s[7 * 33] * sc);
        const int ng = n0 + n; const int drow = (mode == 1) ? (256 * (ng >> 7) + rowoff + (ng & 127)) : (rowoff + ng);
        *(v4u*)(WT + (size_t)drow * ldk + koff + k0 + 8 * c) = o; }
    LDS_WAIT(); asm volatile("" ::: "memory");
}

#define XB_TMO      128
#define XB_XCNT(j)  (256  + 64 * (j))
#define XB_XSUB(j)  (1280 + 64 * (j))
#define XB_XGEN(j)  (2304 + 64 * (j))
#define XB_TOP      3328
#define XB_TOPGEN   3392
#define XCD_BAR_WORDS 3456
#define XB_SPIN_CAP (1u << 18)

__device__ __forceinline__ unsigned xb_ld(unsigned* p)              { return __hip_atomic_load(p, __ATOMIC_RELAXED, __HIP_MEMORY_SCOPE_AGENT); }
__device__ __forceinline__ unsigned xb_add(unsigned* p, unsigned v) { return __hip_atomic_fetch_add(p, v, __ATOMIC_RELAXED, __HIP_MEMORY_SCOPE_AGENT); }
__device__ __forceinline__ unsigned xb_xcc_id() { return (unsigned)__builtin_amdgcn_s_getreg((3 << 11) | 20) & 0xFu; }
#define XB_SPIN(cond, bar) do { unsigned _sp = 0; while (cond) { __builtin_amdgcn_s_sleep(1); \
    if ((++_sp & 255u) == 0u) { if (xb_ld(&(bar)[XB_TMO])) break; if (_sp > XB_SPIN_CAP) { atomicAdd(&(bar)[XB_TMO], 1u); break; } } } } while (0)

struct XcdBarrier {
    unsigned* bar; unsigned x;
    volatile LAS unsigned* st;
};

__device__ __forceinline__ XcdBarrier xcd_barrier_post(unsigned* bar, volatile LAS unsigned* st) {
    XcdBarrier b; b.bar = bar; b.x = xb_xcc_id(); b.st = st;
    if (threadIdx.x == 0) (void)xb_add(&bar[XB_XCNT(b.x)], 1u);
    return b;
}
__device__ __forceinline__ void xcd_barrier_complete(unsigned* bar, unsigned x, unsigned& nloc, unsigned& nx) {
    const unsigned G = gridDim.x * gridDim.y * gridDim.z;
    unsigned sum, cnt, mine, sp = 0u;
    for (;;) {
        sum = 0u; cnt = 0u; mine = 0u;
#pragma unroll
        for (unsigned j = 0; j < 16; ++j) { const unsigned c = xb_ld(&bar[XB_XCNT(j)]); sum += c; cnt += (c > 0u) ? 1u : 0u; mine = (j == x) ? c : mine; }
        if (sum == G) break;
        __builtin_amdgcn_s_sleep(1);
        if ((++sp & 255u) == 0u) { if (xb_ld(&bar[XB_TMO])) break; if (sp > XB_SPIN_CAP) { atomicAdd(&bar[XB_TMO], 1u); break; } }
    }
    nloc = mine > 0u ? mine : 1u; nx = cnt > 0u ? cnt : 1u;
}

__device__ __forceinline__ void xcd_barrier(const XcdBarrier& b) {
    asm volatile("s_waitcnt vmcnt(0)" ::: "memory");
    __syncthreads();
    if (threadIdx.x == 0) {
        unsigned* bar = b.bar;
        __builtin_amdgcn_s_waitcnt(0);
        unsigned nloc = b.st[0], nx = b.st[1];
        if (nloc == 0u) { xcd_barrier_complete(bar, b.x, nloc, nx); b.st[0] = nloc; b.st[1] = nx; }
        const unsigned old = xb_add(&bar[XB_XSUB(b.x)], 1u);
        const unsigned gen = old / nloc;
        if (old + 1u == (gen + 1u) * nloc) {
            __builtin_amdgcn_fence(__ATOMIC_RELEASE, "agent");
            asm volatile("s_waitcnt vmcnt(0)" ::: "memory");
            const unsigned og = xb_add(&bar[XB_TOP], 1u);
            const unsigned tg = og / nx;
            if (og + 1u == (tg + 1u) * nx) xb_add(&bar[XB_TOPGEN], 1u);
            else XB_SPIN(xb_ld(&bar[XB_TOPGEN]) == tg, bar);
            __builtin_amdgcn_fence(__ATOMIC_ACQUIRE, "agent");
            xb_add(&bar[XB_XGEN(b.x)], 1u);
            asm volatile("s_waitcnt vmcnt(0)" ::: "memory");
        } else {
            XB_SPIN(xb_ld(&bar[XB_XGEN(b.x)]) == gen, bar);
            __builtin_amdgcn_fence(__ATOMIC_ACQUIRE, "agent");
            asm volatile("s_waitcnt vmcnt(0)" ::: "memory");
        }
    }
    __syncthreads();
}

struct Args { const float* in[17]; float* out; unsigned char* ws; };

__device__ __forceinline__ void p0_prologue(const Args& a, LAS unsigned char* lds, int gw, int NGW, int wave, int lane) {
    unsigned char* ws = a.ws;
    LAS float* scr = (LAS float*)(lds + wave * 16384);
    constexpr int I_GU = (D / 64) * (FF / 32), I_DN = (FF / 64) * (D / 32), I_IN = (D / 64) * (INC / 32), I_OUT = (HW / 64) * (D / 32);
    constexpr int NITEMS = 4 * I_GU + 2 * I_DN + I_IN + I_OUT;
    for (int it = gw; it < NITEMS; it += NGW) {
        int r = it;
        if (r < I_GU) { transpose_item(a.in[2], FF, (bf16*)(ws + WS_WGU1), D, 0, 1, 0, a.in[1], nullptr, scr, r, lane); continue; } r -= I_GU;
        if (r < I_GU) { transpose_item(a.in[3], FF, (bf16*)(ws + WS_WGU1), D, 0, 1, 128, a.in[1], nullptr, scr, r, lane); continue; } r -= I_GU;
        if (r < I_GU) { transpose_item(a.in[13], FF, (bf16*)(ws + WS_WGU2), D, 0, 1, 0, a.in[12], nullptr, scr, r, lane); continue; } r -= I_GU;
        if (r < I_GU) { transpose_item(a.in[14], FF, (bf16*)(ws + WS_WGU2), D, 0, 1, 128, a.in[12], nullptr, scr, r, lane); continue; } r -= I_GU;
        if (r < I_DN) { transpose_item(a.in[4], D, (bf16*)(ws + WS_WD1), FF, 0, 0, 0, nullptr, nullptr, scr, r, lane); continue; } r -= I_DN;
        if (r < I_DN) { transpose_item(a.in[15], D, (bf16*)(ws + WS_WD2), FF, 0, 0, 0, nullptr, nullptr, scr, r, lane); continue; } r -= I_DN;
        if (r < I_IN) { transpose_item(a.in[6], INC, (bf16*)(ws + WS_WIN), D, 0, 0, 0, a.in[5], nullptr, scr, r, lane); continue; } r -= I_IN;
        transpose_item(a.in[11], D, (bf16*)(ws + WS_WOUT), D, 0, 0, 0, nullptr, nullptr, scr, r + (PW / 64) * (D / 32), lane);
    }
    for (int wi = gw; wi < 2048; wi += NGW) {
        const int n = (wi & 15) * 64 + lane, kq = wi >> 4, g = kq >> 5, c0 = (kq & 31) * 4;
        const float* wo = a.in[11] + (size_t)(g * 128) * D + n; const float* pw = a.in[7] + (size_t)(g * 128 + c0) * 128; const float* ps = a.in[8] + g * 128;
        f32x4 acc4 = (f32x4){0.f, 0.f, 0.f, 0.f};
#pragma unroll 8
        for (int d = 0; d < 128; d += 4) {
            const f32x4 p4 = *(const f32x4*)(ps + d);
            const f32x4 w4 = (f32x4){wo[(size_t)d * D], wo[(size_t)(d + 1) * D], wo[(size_t)(d + 2) * D], wo[(size_t)(d + 3) * D]} * p4;
#pragma unroll
            for (int e = 0; e < 4; ++e) { const f32x4 q4 = *(const f32x4*)(pw + e * 128 + d); acc4[e] += (w4[0] * q4[0] + w4[1] * q4[1]) + (w4[2] * q4[2] + w4[3] * q4[3]); } }
        *(v2u*)((bf16*)(ws + WS_WOUT) + (size_t)n * D + kq * 4) = (v2u){pk2(acc4[0], acc4[1]), pk2(acc4[2], acc4[3])};
    }
    const float* x = a.in[0]; bf16* xb = (bf16*)(ws + WS_ACTB); float* ssq = (float*)(ws + WS_SSQ);
    for (int m = gw; m < M; m += NGW) {
        const f32x4* xr = (const f32x4*)(x + (size_t)m * D) + lane; f32x4 v[4]; float s = 0.f;
#pragma unroll
        for (int j = 0; j < 4; ++j) { v[j] = __builtin_nontemporal_load(xr + 64 * j); s += (v[j].x * v[j].x + v[j].y * v[j].y) + (v[j].z * v[j].z + v[j].w * v[j].w); }
        s = wave_sum(s);
        v2u* o8 = (v2u*)(xb + (size_t)m * D) + lane;
#pragma unroll
        for (int j = 0; j < 4; ++j) o8[64 * j] = (v2u){pk2(v[j].x, v[j].y), pk2(v[j].z, v[j].w)};
        if (lane == 0) { ssq[m] = s; ssq[M + m] = 0.f; ssq[2 * M + m] = 0.f; ssq[3 * M + m] = 0.f; }
    }
    if (gw < 16) { const int i = gw * 64 + lane; const int d = i >> 9, w = i & 511; const float a0 = a.in[9][d * 1024 + w], a1 = a.in[9][d * 1024 + 512 + w];
        ((float*)(ws + WS_OMLB))[i] = 1.0f / (1.0f + expf(a0 - a1)); }
}

__device__ __forceinline__ void pool_rows(const bf16* proj, bf16* pooled, int gw, int NGW, int lane) {
    const int g = lane >> 4, half = 1 << g;
    float mul[16];
#pragma unroll
    for (int d = 0; d < 16; ++d) mul[d] = (d - 8 >= -half && d - 8 < half) ? 1.0f : 0.0f;
    for (int blk = gw; blk < M / 8; blk += NGW) {
        const int m0 = blk * 8, t0 = m0 & (SEQ - 1);
        const bf16* base = proj + (size_t)(m0 - t0) * INC + lane * 8;
        v4u z[24];
#pragma unroll
        for (int j = 0; j < 24; ++j) { const int t = t0 - 8 + j; z[j] = (t >= 0 && t < SEQ) ? __builtin_nontemporal_load((const v4u*)(base + (size_t)t * INC)) : (v4u){0u, 0u, 0u, 0u}; }
#pragma unroll
        for (int r = 0; r < 8; ++r) {
            float s[8];
#pragma unroll
            for (int e = 0; e < 8; ++e) s[e] = 0.f;
#pragma unroll
            for (int d = 0; d < 16; ++d) { const v4u w = z[r + d]; const float ml = mul[d];
                s[0] += ml * bflo(w.x); s[1] += ml * bfhi(w.x); s[2] += ml * bflo(w.y); s[3] += ml * bfhi(w.y); s[4] += ml * bflo(w.z); s[5] += ml * bfhi(w.z); s[6] += ml * bflo(w.w); s[7] += ml * bfhi(w.w); }
            const int t = t0 + r; const int lo = (t - half) < 0 ? 0 : (t - half), hi = (t + half) > SEQ ? SEQ : (t + half);
            const float inv = 1.0f / (float)(hi - lo); const v4u zc = z[r + 8];
            v4u o; o.x = pk2(s[0] * inv - bflo(zc.x), s[1] * inv - bfhi(zc.x)); o.y = pk2(s[2] * inv - bflo(zc.y), s[3] * inv - bfhi(zc.y));
            o.z = pk2(s[4] * inv - bflo(zc.z), s[5] * inv - bfhi(zc.z)); o.w = pk2(s[6] * inv - bflo(zc.w), s[7] * inv - bfhi(zc.w));
            __builtin_nontemporal_store(o, (v4u*)(pooled + (size_t)(m0 + r) * D + lane * 8));
        }
    }
}

typedef short bf16x8 __attribute__((ext_vector_type(8)));
__device__ __forceinline__ f32x4 mfma16(bf16x8 x, bf16x8 y, f32x4 c) { return __builtin_amdgcn_mfma_f32_16x16x32_bf16(x, y, c, 0, 0, 0); }
constexpr int TR_STRIDE = 144;
constexpr int CH_STRIDE = 272;

__device__ __forceinline__ float fast_ln(float x) { return __builtin_amdgcn_logf(x) * 0.69314718f; }
constexpr float ST_SCALE = 8.0f, ST_INV = 1.0f / 8.0f, ST_MAX = 440.0f;
__device__ __forceinline__ float st_clamp(float x) { return fminf(fmaxf(x, -ST_MAX), ST_MAX); }
__device__ __forceinline__ unsigned pack_fp8x4(float a, float b, float c, float d) {
    int w = 0; w = __builtin_amdgcn_cvt_pk_fp8_f32(st_clamp(a), st_clamp(b), w, false); w = __builtin_amdgcn_cvt_pk_fp8_f32(st_clamp(c), st_clamp(d), w, true); return (unsigned)w; }
__device__ __forceinline__ f32x4 unpack_fp8x4(unsigned w) { const f32x2 lo = __builtin_amdgcn_cvt_pk_f32_fp8((int)w, false), hi = __builtin_amdgcn_cvt_pk_f32_fp8((int)w, true); return (f32x4){lo.x, lo.y, hi.x, hi.y}; }

struct HlP { unsigned rv[8], rkf[8], rkb[8]; };
__device__ __forceinline__ void hgrn_local_loadp(const bf16* proj, int it, int tid, HlP& P) {
    const int b = it >> 9, head = (it >> 7) & 3, c = it & 127, cp = tid & 63, pg = __builtin_amdgcn_readfirstlane(tid >> 6);
    const bf16* pv = proj + ((size_t)b * SEQ + c * 64 + pg * 8) * INC + 1024 + head * 128 + 2 * cp;
#pragma unroll
    for (int i = 0; i < 8; ++i) { P.rv[i] = __builtin_nontemporal_load((const unsigned*)(pv + (size_t)i * INC)); P.rkf[i] = __builtin_nontemporal_load((const unsigned*)(pv + (size_t)i * INC + 512)); P.rkb[i] = __builtin_nontemporal_load((const unsigned*)(pv + (size_t)i * INC + 1024)); }
}
__device__ __forceinline__ void hgrn_local_item(const bf16* proj, bf16* LT, float* DV, LAS unsigned char* lds, int it, int tid, const HlP& R, int it_next, HlP& NX) {
    const int b = it >> 9, head = (it >> 7) & 3, c = it & 127;
    const int cp = tid & 63, pg = __builtin_amdgcn_readfirstlane(tid >> 6), lane = tid & 63, fr = lane & 15, fq = lane >> 4;
    LAS unsigned char* VT = lds;
    LAS unsigned char* KF = lds + 128 * TR_STRIDE;
    LAS unsigned char* KB = lds + 2 * 128 * TR_STRIDE;
    LAS float* TF = (LAS float*)(lds + 3 * 128 * TR_STRIDE);
    LAS float* TB = TF + 1024;
    float gf[8][2], gb[8][2]; float tf0 = 0.f, tf1 = 0.f, tb0 = 0.f, tb1 = 0.f;
#pragma unroll
    for (int i = 0; i < 8; ++i) { gf[i][0] = fast_ln(1.0f - bflo(R.rkf[i])); gf[i][1] = fast_ln(1.0f - bfhi(R.rkf[i])); gb[i][0] = fast_ln(1.0f - bflo(R.rkb[i])); gb[i][1] = fast_ln(1.0f - bfhi(R.rkb[i]));
        tf0 += gf[i][0]; tf1 += gf[i][1]; tb0 += gb[i][0]; tb1 += gb[i][1]; }
    *(LAS f32x2*)(TF + pg * 128 + 2 * cp) = (f32x2){tf0, tf1}; *(LAS f32x2*)(TB + pg * 128 + 2 * cp) = (f32x2){tb0, tb1};
    { v4u w0, w1;
      w0.x = (R.rv[0] & 0xffffu) | (R.rv[1] << 16); w0.y = (R.rv[2] & 0xffffu) | (R.rv[3] << 16); w0.z = (R.rv[4] & 0xffffu) | (R.rv[5] << 16); w0.w = (R.rv[6] & 0xffffu) | (R.rv[7] << 16);
      w1.x = (R.rv[0] >> 16) | (R.rv[1] & 0xffff0000u); w1.y = (R.rv[2] >> 16) | (R.rv[3] & 0xffff0000u); w1.z = (R.rv[4] >> 16) | (R.rv[5] & 0xffff0000u); w1.w = (R.rv[6] >> 16) | (R.rv[7] & 0xffff0000u);
      *(LAS v4u*)(VT + (2 * cp) * TR_STRIDE + pg * 16) = w0; *(LAS v4u*)(VT + (2 * cp + 1) * TR_STRIDE + pg * 16) = w1; }
    __syncthreads();
    if (it_next >= 0) hgrn_local_loadp(proj, it_next, tid, NX);
    float af0 = 0.f, af1 = 0.f, bb0 = 0.f, bb1 = 0.f, sf0 = 0.f, sf1 = 0.f, sb0 = 0.f, sb1 = 0.f;
#pragma unroll
    for (int p = 0; p < 8; ++p) { const f32x2 a = *(const LAS f32x2*)(TF + p * 128 + 2 * cp), bq = *(const LAS f32x2*)(TB + p * 128 + 2 * cp);
        sf0 += a.x; sf1 += a.y; sb0 += bq.x; sb1 += bq.y; if (p > pg) { af0 += a.x; af1 += a.y; } if (p < pg) { bb0 += bq.x; bb1 += bq.y; } }
    const int seqf = (b * 4 + head) * 128 + c, seqb = ((32 + b * 4 + head)) * 128 + c;
    if (pg == 0) { *(f32x2*)(DV + (size_t)seqf * 128 + 2 * cp) = (f32x2){__expf(sf0), __expf(sf1)}; *(f32x2*)(DV + (size_t)seqb * 128 + 2 * cp) = (f32x2){__expf(sb0), __expf(sb1)}; }
    { float kd[8][2];
#pragma unroll
      for (int i = 7; i >= 0; --i) { kd[i][0] = bflo(R.rkf[i]) * __expf(af0); kd[i][1] = bfhi(R.rkf[i]) * __expf(af1); af0 += gf[i][0]; af1 += gf[i][1]; }
      v4u w0, w1; w0.x = pk2(kd[0][0], kd[1][0]); w0.y = pk2(kd[2][0], kd[3][0]); w0.z = pk2(kd[4][0], kd[5][0]); w0.w = pk2(kd[6][0], kd[7][0]);
      w1.x = pk2(kd[0][1], kd[1][1]); w1.y = pk2(kd[2][1], kd[3][1]); w1.z = pk2(kd[4][1], kd[5][1]); w1.w = pk2(kd[6][1], kd[7][1]);
      *(LAS v4u*)(KF + (2 * cp) * TR_STRIDE + pg * 16) = w0; *(LAS v4u*)(KF + (2 * cp + 1) * TR_STRIDE + pg * 16) = w1;
#pragma unroll
      for (int i = 0; i < 8; ++i) { kd[i][0] = bflo(R.rkb[i]) * __expf(bb0); kd[i][1] = bfhi(R.rkb[i]) * __expf(bb1); bb0 += gb[i][0]; bb1 += gb[i][1]; }
      w0.x = pk2(kd[0][0], kd[1][0]); w0.y = pk2(kd[2][0], kd[3][0]); w0.z = pk2(kd[4][0], kd[5][0]); w0.w = pk2(kd[6][0], kd[7][0]);
      w1.x = pk2(kd[0][1], kd[1][1]); w1.y = pk2(kd[2][1], kd[3][1]); w1.z = pk2(kd[4][1], kd[5][1]); w1.w = pk2(kd[6][1], kd[7][1]);
      *(LAS v4u*)(KB + (2 * cp) * TR_STRIDE + pg * 16) = w0; *(LAS v4u*)(KB + (2 * cp + 1) * TR_STRIDE + pg * 16) = w1; }
    __syncthreads();
    { const int dir = pg >> 2, tv0 = 2 * (pg & 3); const LAS unsigned char* KD = dir ? KB : KF;
      unsigned char* out = (unsigned char*)LT + (size_t)(dir ? seqb : seqf) * 16384;
      bf16x8 y0[2], y1[2];
#pragma unroll
      for (int ks = 0; ks < 2; ++ks) { y0[ks] = *(const LAS bf16x8*)(VT + (16 * tv0 + fr) * TR_STRIDE + (32 * ks + 8 * fq) * 2); y1[ks] = *(const LAS bf16x8*)(VT + (16 * tv0 + 16 + fr) * TR_STRIDE + (32 * ks + 8 * fq) * 2); }
#pragma unroll
      for (int tk = 0; tk < 8; ++tk) { f32x4 a0 = (f32x4){0.f, 0.f, 0.f, 0.f}, a1 = a0;
#pragma unroll
          for (int ks = 0; ks < 2; ++ks) { const bf16x8 x = *(const LAS bf16x8*)(KD + (16 * tk + fr) * TR_STRIDE + (32 * ks + 8 * fq) * 2); a0 = mfma16(x, y0[ks], a0); a1 = mfma16(x, y1[ks], a1); }
          *(unsigned*)(out + (size_t)(16 * tv0 + fr) * 128 + 16 * tk + 4 * fq) = pack_fp8x4(a0[0] * ST_SCALE, a0[1] * ST_SCALE, a0[2] * ST_SCALE, a0[3] * ST_SCALE);
          *(unsigned*)(out + (size_t)(16 * tv0 + 16 + fr) * 128 + 16 * tk + 4 * fq) = pack_fp8x4(a1[0] * ST_SCALE, a1[1] * ST_SCALE, a1[2] * ST_SCALE, a1[3] * ST_SCALE); } }
    __syncthreads();
}

__device__ __forceinline__ void hgrn_state_scan(bf16* LT, const float* DV, int T, int NT) {
    for (int x = T; x < 64 * 2048; x += NT) {
        const int seqi = x >> 11, e8 = x & 2047, dir = seqi >> 5, k0 = (e8 & 15) * 8;
        unsigned char* base = (unsigned char*)LT + (size_t)seqi * 128 * 16384 + e8 * 8; const float* dbase = DV + (size_t)seqi * 128 * 128 + k0;
        f32x4 S0 = (f32x4){0.f, 0.f, 0.f, 0.f}, S1 = S0;
        for (int cc = 0; cc < 128; cc += 8) {
            v2u L[8]; f32x4 d0[8], d1[8];
#pragma unroll
            for (int j = 0; j < 8; ++j) { const int c = dir ? (127 - cc - j) : (cc + j); L[j] = __builtin_nontemporal_load((const v2u*)(base + (size_t)c * 16384)); d0[j] = *(const f32x4*)(dbase + c * 128); d1[j] = *(const f32x4*)(dbase + c * 128 + 4); }
#pragma unroll
            for (int j = 0; j < 8; ++j) { const int c = dir ? (127 - cc - j) : (cc + j);
                *(v2u*)(base + (size_t)c * 16384) = (v2u){pack_fp8x4(S0[0], S0[1], S0[2], S0[3]), pack_fp8x4(S1[0], S1[1], S1[2], S1[3])};
                S0 = d0[j] * S0 + unpack_fp8x4(L[j].x); S1 = d1[j] * S1 + unpack_fp8x4(L[j].y); }
        }
    }
}

__device__ __forceinline__ bf16x8 frag_fp8(const LAS unsigned char* p) {
    const v2u w = *(const LAS v2u*)p; const f32x4 a = unpack_fp8x4(w.x), c = unpack_fp8x4(w.y);
    return __builtin_bit_cast(bf16x8, (v4u){pk2(a[0], a[1]), pk2(a[2], a[3]), pk2(c[0], c[1]), pk2(c[2], c[3])});
}
struct HoP { unsigned rq[8], rv[8], rkf[8], rkb[8]; v4u rawS[2][2]; };
__device__ __forceinline__ void hgrn_out_loadp(const bf16* proj, const bf16* LT, int it, int tid, HoP& P) {
    const int b = it >> 9, head = (it >> 7) & 3, c = it & 127, cp = tid & 63, pg = __builtin_amdgcn_readfirstlane(tid >> 6);
    const bf16* pq = proj + ((size_t)b * SEQ + c * 64 + pg * 8) * INC + 512 + head * 128 + 2 * cp;
#pragma unroll
    for (int i = 0; i < 8; ++i) { P.rq[i] = __builtin_nontemporal_load((const unsigned*)(pq + (size_t)i * INC)); P.rv[i] = __builtin_nontemporal_load((const unsigned*)(pq + (size_t)i * INC + 512));
        P.rkf[i] = __builtin_nontemporal_load((const unsigned*)(pq + (size_t)i * INC + 1024)); P.rkb[i] = __builtin_nontemporal_load((const unsigned*)(pq + (size_t)i * INC + 1536)); }
#pragma unroll
    for (int dd = 0; dd < 2; ++dd) { const unsigned char* Sg = (const unsigned char*)LT + ((size_t)((dd * 32 + b * 4 + head) * 128 + c)) * 16384;
#pragma unroll
        for (int i = 0; i < 2; ++i) P.rawS[dd][i] = __builtin_nontemporal_load((const v4u*)(Sg + (size_t)(tid + 512 * i) * 16)); }
}
__device__ __forceinline__ void hgrn_out_item(const bf16* proj, const bf16* LT, const float* gnorm, bf16* ymix, LAS unsigned char* lds, int it, int tid, const HoP& R, int it_next, HoP& NX) {
    const int b = it >> 9, head = (it >> 7) & 3, c = it & 127;
    const int cp = tid & 63, pg = __builtin_amdgcn_readfirstlane(tid >> 6), lane = tid & 63, fr = lane & 15, fq = lane >> 4;
    LAS unsigned char* QTB = lds;
    LAS unsigned char* KTB = lds + 64 * CH_STRIDE;
    LAS unsigned char* VT = lds + 256 * CH_STRIDE;
    LAS unsigned char* PP = VT + 128 * TR_STRIDE;
    LAS unsigned char* S8 = PP + 64 * TR_STRIDE;
    LAS float* TF = (LAS float*)(S8 + 2 * 128 * TR_STRIDE);
    LAS float* TB = TF + 1024;
    LAS float* RS = TB + 1024;
    const int ti = pg & 3, hv = pg >> 2;
    v2u gzr[4];
    { const size_t rowg = (size_t)b * SEQ + c * 64 + 16 * ti + fr;
#pragma unroll
      for (int t = 0; t < 4; ++t) gzr[t] = __builtin_nontemporal_load((const v2u*)(proj + rowg * INC + 2560 + head * 128 + 64 * hv + 16 * t + 4 * fq)); }
    { float tf0 = 0.f, tf1 = 0.f, tb0 = 0.f, tb1 = 0.f;
#pragma unroll
      for (int i = 0; i < 8; ++i) { tf0 += fast_ln(1.0f - bflo(R.rkf[i])); tf1 += fast_ln(1.0f - bfhi(R.rkf[i])); tb0 += fast_ln(1.0f - bflo(R.rkb[i])); tb1 += fast_ln(1.0f - bfhi(R.rkb[i])); }
      *(LAS f32x2*)(TF + pg * 128 + 2 * cp) = (f32x2){tf0, tf1}; *(LAS f32x2*)(TB + pg * 128 + 2 * cp) = (f32x2){tb0, tb1};
      v4u w0, w1;
      w0.x = (R.rv[0] & 0xffffu) | (R.rv[1] << 16); w0.y = (R.rv[2] & 0xffffu) | (R.rv[3] << 16); w0.z = (R.rv[4] & 0xffffu) | (R.rv[5] << 16); w0.w = (R.rv[6] & 0xffffu) | (R.rv[7] << 16);
      w1.x = (R.rv[0] >> 16) | (R.rv[1] & 0xffff0000u); w1.y = (R.rv[2] >> 16) | (R.rv[3] & 0xffff0000u); w1.z = (R.rv[4] >> 16) | (R.rv[5] & 0xffff0000u); w1.w = (R.rv[6] >> 16) | (R.rv[7] & 0xffff0000u);
      *(LAS v4u*)(VT + (2 * cp) * TR_STRIDE + pg * 16) = w0; *(LAS v4u*)(VT + (2 * cp + 1) * TR_STRIDE + pg * 16) = w1; }
    __syncthreads();
    if (it_next < 4096) hgrn_out_loadp(proj, LT, it_next, tid, NX);
#pragma unroll
    for (int dir = 0; dir < 2; ++dir) {
        const LAS float* TT = dir ? TB : TF; float o0 = 0.f, o1 = 0.f;
        LAS unsigned char* QT = QTB + dir * 128 * CH_STRIDE; LAS unsigned char* KT = KTB + dir * 128 * CH_STRIDE;
#pragma unroll
        for (int p = 0; p < 8; ++p) { const f32x2 a = *(const LAS f32x2*)(TT + p * 128 + 2 * cp); if (dir ? (p > pg) : (p < pg)) { o0 += a.x; o1 += a.y; } }
#pragma unroll
        for (int ii = 0; ii < 8; ++ii) { const int i = dir ? (7 - ii) : ii; const unsigned rk = dir ? R.rkb[i] : R.rkf[i];
            const float k0 = bflo(rk), k1 = bfhi(rk); o0 += fast_ln(1.0f - k0); o1 += fast_ln(1.0f - k1);
            const float e0 = __expf(o0), e1 = __expf(o1), n0 = __expf(-o0), n1 = __expf(-o1);
            *(LAS unsigned*)(QT + (8 * pg + i) * CH_STRIDE + 4 * cp) = pk2(bflo(R.rq[i]) * e0, bfhi(R.rq[i]) * e1);
            *(LAS unsigned*)(KT + (8 * pg + i) * CH_STRIDE + 4 * cp) = pk2(k0 * n0, k1 * n1); }
    }
#pragma unroll
    for (int dd = 0; dd < 2; ++dd)
#pragma unroll
        for (int i = 0; i < 2; ++i) { const int e = tid + 512 * i; *(LAS v4u*)(S8 + dd * 128 * TR_STRIDE + (e >> 3) * TR_STRIDE + (e & 7) * 16) = R.rawS[dd][i]; }
    __syncthreads();
    bf16x8 yq[2][4];
#pragma unroll
    for (int dir = 0; dir < 2; ++dir)
#pragma unroll
        for (int ks = 0; ks < 4; ++ks) yq[dir][ks] = *(const LAS bf16x8*)(QTB + dir * 128 * CH_STRIDE + (16 * ti + fr) * CH_STRIDE + (32 * ks + 8 * fq) * 2);
#pragma unroll
    for (int jj = 0; jj < 2; ++jj) { const int tj = 2 * hv + jj; f32x4 st = (f32x4){0.f, 0.f, 0.f, 0.f};
        const int ipos = 16 * ti + fr, j0 = 16 * tj + 4 * fq;
#pragma unroll
        for (int dir = 0; dir < 2; ++dir) {
            if (dir ? (tj >= ti) : (tj <= ti)) { f32x4 sd = (f32x4){0.f, 0.f, 0.f, 0.f};
#pragma unroll
                for (int ks = 0; ks < 4; ++ks) { const bf16x8 x = *(const LAS bf16x8*)(KTB + dir * 128 * CH_STRIDE + (16 * tj + fr) * CH_STRIDE + (32 * ks + 8 * fq) * 2); sd = mfma16(x, yq[dir][ks], sd); }
#pragma unroll
                for (int e = 0; e < 4; ++e) { const bool keep = dir ? (j0 + e >= ipos) : (j0 + e <= ipos); st[e] += keep ? sd[e] : 0.f; } } }
        *(LAS v2u*)(PP + (16 * ti + fr) * TR_STRIDE + (16 * tj + 4 * fq) * 2) = (v2u){pk2(st[0], st[1]), pk2(st[2], st[3])}; }
    __syncthreads();
    f32x4 acc[4], acci[4];
    { bf16x8 yp[2];
#pragma unroll
      for (int ks = 0; ks < 2; ++ks) yp[ks] = *(const LAS bf16x8*)(PP + (16 * ti + fr) * TR_STRIDE + (32 * ks + 8 * fq) * 2);
#pragma unroll
      for (int t = 0; t < 4; ++t) { const int tv = 4 * hv + t; acc[t] = (f32x4){0.f, 0.f, 0.f, 0.f}; acci[t] = acc[t];
#pragma unroll
          for (int ks = 0; ks < 2; ++ks) { const bf16x8 x = *(const LAS bf16x8*)(VT + (16 * tv + fr) * TR_STRIDE + (32 * ks + 8 * fq) * 2); acc[t] = mfma16(x, yp[ks], acc[t]); }
#pragma unroll
          for (int dir = 0; dir < 2; ++dir)
#pragma unroll
              for (int ks = 0; ks < 4; ++ks) { const bf16x8 x = frag_fp8(S8 + dir * 128 * TR_STRIDE + (16 * tv + fr) * TR_STRIDE + 32 * ks + 8 * fq); acci[t] = mfma16(x, yq[dir][ks], acci[t]); }
          acc[t] = acc[t] + acci[t] * ST_INV; } }
    float ss = 0.f;
#pragma unroll
    for (int t = 0; t < 4; ++t) ss += (acc[t][0] * acc[t][0] + acc[t][1] * acc[t][1]) + (acc[t][2] * acc[t][2] + acc[t][3] * acc[t][3]);
    ss += __shfl_xor(ss, 16); ss += __shfl_xor(ss, 32);
    if (fq == 0) RS[hv * 64 + 16 * ti + fr] = ss;
    __syncthreads();
    const float r = __builtin_amdgcn_rsqf((RS[16 * ti + fr] + RS[64 + 16 * ti + fr]) * (1.0f / 128.0f) + EPS);
    const size_t row = (size_t)b * SEQ + c * 64 + 16 * ti + fr;
#pragma unroll
    for (int t = 0; t < 4; ++t) { const int vcol = 64 * hv + 16 * t + 4 * fq; const f32x4 gn = *(const f32x4*)(gnorm + vcol);
        const v2u gz = gzr[t];
        *(v2u*)(ymix + row * D + 512 + head * 128 + vcol) = (v2u){pk2(acc[t][0] * r * gn[0] * bflo(gz.x), acc[t][1] * r * gn[1] * bfhi(gz.x)), pk2(acc[t][2] * r * gn[2] * bflo(gz.y), acc[t][3] * r * gn[3] * bfhi(gz.y))}; }
}

__device__ __forceinline__ void final_norm(const bf16* hb, float* out, const float* ssq3, const float* wf, int gw, int NGW, int lane) {
    f32x4 w4[4];
#pragma unroll
    for (int j = 0; j < 2; ++j) { w4[2 * j] = *(const f32x4*)(wf + 512 * j + lane * 8); w4[2 * j + 1] = *(const f32x4*)(wf + 512 * j + lane * 8 + 4); }
    for (int m = gw; m < M; m += NGW) {
        const float r = __builtin_amdgcn_rsqf(ssq3[m] * (1.0f / 1024.0f) + EPS);
        const v4u h0 = __builtin_nontemporal_load((const v4u*)(hb + (size_t)m * D + lane * 8)), h1 = __builtin_nontemporal_load((const v4u*)(hb + (size_t)m * D + 512 + lane * 8));
        float* o = out + (size_t)m * D + lane * 8;
        __builtin_nontemporal_store((f32x4){bflo(h0.x), bfhi(h0.x), bflo(h0.y), bfhi(h0.y)} * r * w4[0], (f32x4*)(o));
        __builtin_nontemporal_store((f32x4){bflo(h0.z), bfhi(h0.z), bflo(h0.w), bfhi(h0.w)} * r * w4[1], (f32x4*)(o + 4));
        __builtin_nontemporal_store((f32x4){bflo(h1.x), bfhi(h1.x), bflo(h1.y), bfhi(h1.y)} * r * w4[2], (f32x4*)(o + 512));
        __builtin_nontemporal_store((f32x4){bflo(h1.z), bfhi(h1.z), bflo(h1.w), bfhi(h1.w)} * r * w4[3], (f32x4*)(o + 516));
    }
}

__global__ void __launch_bounds__(NWAVES * 64, 2) mk_fwd(Args args) {
    extern __shared__ __attribute__((aligned(16))) unsigned char lds_raw[];
    cg::grid_group grid = cg::this_grid();
    LAS unsigned char* lds = (LAS unsigned char*)lds_raw;
    const int tid = threadIdx.x, lane = tid & 63, wave = __builtin_amdgcn_readfirstlane(tid >> 6);
    const int G = gridDim.x, bx = blockIdx.x;
    const int vcu = (G % 8 == 0) ? (bx % 8) * (G / 8) + bx / 8 : bx;
    const int gw = vcu * NWAVES + wave, NGW = G * NWAVES;
    unsigned char* ws = args.ws;
    float* ssq = (float*)(ws + WS_SSQ);
    bf16* actb = (bf16*)(ws + WS_ACTB); bf16* ymix = (bf16*)(ws + WS_YMIX); bf16* proj = (bf16*)(ws + WS_PROJ); bf16* hid = (bf16*)(ws + WS_PROJ);
    bf16* LT = (bf16*)(ws + WS_LT); float* DV = args.out; bf16* pooled = (bf16*)(ws + WS_POOLED);

    volatile LAS unsigned* MISC = (volatile LAS unsigned*)(lds + 143360);
    if (tid < 32) MISC[tid] = 0u;
    __syncthreads();
    const XcdBarrier bar = xcd_barrier_post((unsigned*)(ws + WS_BAR), MISC + 8);
    p0_prologue(args, lds, gw, NGW, wave, lane);
    if (args.ws == nullptr) grid.sync();
    xcd_barrier(bar);
    { pg8::Gemm g{actb, (const bf16*)(ws + WS_WGU1), M, 2 * FF, D}; pg8::StaticOrder S; S.init(M, 2 * FF, G, bx);
      pg8::EpiSwiglu E{hid, FF, ssq};
      pg8::gemm_phase<pg8::EpiSwiglu, pg8::StaticOrder, true, true>(lds, g, S, E); }
    xcd_barrier(bar);
    { pg8::Gemm g{hid, (const bf16*)(ws + WS_WD1), M, D, FF}; pg8::StaticOrder S; S.init(M, D, G, bx, 1);
      pg8::EpiResid E{actb, ssq + M, 0.5f, D};
      pg8::gemm_phase<pg8::EpiResid, pg8::StaticOrder, true, true>(lds, g, S, E); }
    xcd_barrier(bar);
    { pg8::Gemm g{actb, (const bf16*)(ws + WS_WIN), M, INC, D}; pg8::StaticOrder S; S.init(M, INC, G, bx);
      pg8::EpiProj E{proj, INC, ssq + M, (const float*)(ws + WS_OMLB)};
      pg8::gemm_phase<pg8::EpiProj, pg8::StaticOrder, true, true>(lds, g, S, E); }
    xcd_barrier(bar);
    pool_rows(proj, ymix, gw, NGW, lane);
    { HlP LA, LB; int it = bx;
      if (it < 4096) hgrn_local_loadp(proj, it, tid, LA);
      for (; it < 4096; it += 2 * G) {
          hgrn_local_item(proj, LT, DV, lds, it, tid, LA, (it + G < 4096) ? it + G : -1, LB);
          if (it + G < 4096) hgrn_local_item(proj, LT, DV, lds, it + G, tid, LB, (it + 2 * G < 4096) ? it + 2 * G : -1, LA); } }
    xcd_barrier(bar);
    hgrn_state_scan(LT, DV, bx * (NWAVES * 64) + tid, G * NWAVES * 64);
    xcd_barrier(bar);
    { HoP PA, PB; int it = bx;
      if (it < 4096) hgrn_out_loadp(proj, LT, it, tid, PA);
      for (; it < 4096; it += 2 * G) {
          hgrn_out_item(proj, LT, args.in[10], ymix, lds, it, tid, PA, it + G, PB);
          if (it + G < 4096) hgrn_out_item(proj, LT, args.in[10], ymix, lds, it + G, tid, PB, it + 2 * G, PA); } }
    xcd_barrier(bar);
    { pg8::Gemm g{ymix, (const bf16*)(ws + WS_WOUT), M, D, D}; pg8::StaticOrder S; S.init(M, D, G, bx);
      pg8::EpiResid E{actb, ssq + 2 * M, 1.0f, D};
      pg8::gemm_phase<pg8::EpiResid, pg8::StaticOrder, true, true>(lds, g, S, E); }
    xcd_barrier(bar);
    { pg8::Gemm g{actb, (const bf16*)(ws + WS_WGU2), M, 2 * FF, D}; pg8::StaticOrder S; S.init(M, 2 * FF, G, bx);
      pg8::EpiSwiglu E{hid, FF, ssq + 2 * M};
      pg8::gemm_phase<pg8::EpiSwiglu, pg8::StaticOrder, true, true>(lds, g, S, E); }
    xcd_barrier(bar);
    { pg8::Gemm g{hid, (const bf16*)(ws + WS_WD2), M, D, FF}; pg8::StaticOrder S; S.init(M, D, G, bx, 1);
      pg8::EpiResid E{actb, ssq + 3 * M, 0.5f, D};
      pg8::gemm_phase<pg8::EpiResid, pg8::StaticOrder, true, true>(lds, g, S, E); }
    xcd_barrier(bar);
    final_norm(actb, args.out, ssq + 3 * M, args.in[16], gw, NGW, lane);
}

extern "C" void kernel_launch(void* const* d_in, const int* in_sizes, int n_in, void* d_out, int out_size, void* d_ws, size_t ws_size, hipStream_t stream) {
    static int grid = 0;
    if (grid == 0) {
        if (n_in != 17 || in_sizes[0] != M * D || out_size != M * D || ws_size < WS_END) { fprintf(stderr, "kernel_launch: unexpected shapes: n_in %d in0 %d out %d ws %zu\n", n_in, n_in > 0 ? in_sizes[0] : -1, out_size, ws_size); grid = -1; return; }
        int dev = 0, cus = 0, per_cu = 0;
        if (hipGetDevice(&dev) != hipSuccess || hipDeviceGetAttribute(&cus, hipDeviceAttributeMultiprocessorCount, dev) != hipSuccess) { grid = -1; return; }
        if (hipFuncSetAttribute((const void*)mk_fwd, hipFuncAttributeMaxDynamicSharedMemorySize, LDS_BYTES) != hipSuccess) { fprintf(stderr, "kernel_launch: hipFuncSetAttribute failed\n"); grid = -1; return; }
        if (hipOccupancyMaxActiveBlocksPerMultiprocessor(&per_cu, (const void*)mk_fwd, NWAVES * 64, LDS_BYTES) != hipSuccess || per_cu < 1) { fprintf(stderr, "kernel_launch: occupancy query says %d\n", per_cu); per_cu = 1; }
        (void)hipGetLastError();
        grid = cus * 1;
    }
    if (grid < 0) return;
    if (hipMemsetAsync((char*)d_ws + WS_BAR, 0, 16384, stream) != hipSuccess) { fprintf(stderr, "kernel_launch: memset of barrier words failed\n"); return; }
    Args a{};
    for (int i = 0; i < 17; ++i) a.in[i] = (const float*)d_in[i];
    a.out = (float*)d_out; a.ws = (unsigned char*)d_ws;
    void* kargs[] = {&a};
    hipError_t e = hipLaunchCooperativeKernel((const void*)mk_fwd, dim3(grid), dim3(NWAVES * 64), kargs, LDS_BYTES, stream);
    if (e != hipSuccess) fprintf(stderr, "kernel_launch: cooperative launch failed: %s (grid %d)\n", hipGetErrorString(e), grid);
}
```

```cpp
#include <hip/hip_runtime.h>
#include <hip/hip_cooperative_groups.h>
#include <cstdio>
#include <cstdint>
namespace cg = cooperative_groups;
namespace pg8 {
#define PG8_LAS __attribute__((address_space(3)))
typedef unsigned short bf16_t;
typedef short bf16x8 __attribute__((ext_vector_type(8)));
typedef float f32x4 __attribute__((ext_vector_type(4)));
typedef unsigned u32x4 __attribute__((ext_vector_type(4)));
constexpr int BM = 256, BK = 64, HALF = 128, HTB = HALF * BK * 2  , STAGE_BYTES = 8 * HTB, NXCD = 8, WGM = 8;

__host__ __device__ __forceinline__ int lds_byte(int r, int c) { const int st = (r >> 4) * 2 + (c >> 5), rr = r & 15, cc = c & 31, ob = rr * 64 + cc * 2; return st * 1024 + (ob ^ (((ob >> 9) & 1) << 5)); }
__host__ __device__ __forceinline__ void stage_rc(int b, int& R, int& C) { const int st = b / 1024, sb = b % 1024, swz = sb ^ (((sb >> 9) & 1) << 5); R = (st >> 1) * 16 + swz / 64; C = (st & 1) * 32 + (swz % 64) / 2; }
__host__ __device__ __forceinline__ int perm32(int rho) { const int n = rho >> 4, i = rho & 15; return 8 * (i >> 2) + 4 * n + (i & 3); }

struct Unit { int pm, pn; };
struct Gemm { const bf16_t* A; const bf16_t* Bt; int M, N, K; };

struct StaticOrder {
    int nM, nN, nwg, G, c, rev;
    __host__ __device__ void init(int M, int N, int G_, int c_, int rev_ = 0) { nM = M / BM; nN = N / BM; nwg = nM * nN; G = G_; c = c_; rev = rev_; }
    __host__ __device__ bool next(int i, Unit& u) const {
        const long L = (long)i * G + c; if (L >= nwg) return false;
        int wgid = (int)L; { const int q = nwg / NXCD, r = nwg % NXCD, xcd = wgid % NXCD; int off = wgid / NXCD; if (rev && r == 0) off = q - 1 - off; wgid = (xcd < r ? xcd * (q + 1) : r * (q + 1) + (xcd - r) * q) + off; }
        const int nig = WGM * nN, gid = wgid / nig, fm = gid * WGM, gsz = (nM - fm) < WGM ? (nM - fm) : WGM;
        u.pm = fm + ((wgid % nig) % gsz); u.pn = (wgid % nig) / gsz; return true;
    }
    __device__ __forceinline__ void a_ready(const Unit&) const {}
    __device__ __forceinline__ void done(const Unit&) const {}
};
typedef float f32x2 __attribute__((ext_vector_type(2)));
typedef __bf16 bf16x2_t __attribute__((ext_vector_type(2)));
__device__ __forceinline__ unsigned cvt_pk_bf16(float lo, float hi) { f32x2 v = {lo, hi}; bf16x2_t b = __builtin_convertvector(v, bf16x2_t); return __builtin_bit_cast(unsigned, b); }

constexpr float RMS_EPS = 1e-6f;
__device__ __forceinline__ float fast_sigmoid(float v) { return __builtin_amdgcn_rcpf(1.0f + __expf(-v)); }
__device__ __forceinline__ float silu_f(float v) { return v * fast_sigmoid(v); }

struct EpiSwiglu {
    static constexpr bool PERM = true, AFTER_DRAIN = false;
    bf16_t* O; int ldc; const float* ssq;
    __device__ __forceinline__ void prefetch(const Unit& u, int wr, int wc, int fr, int fq, float (&pf)[8]) const {
#pragma unroll
        for (int i = 0; i < 8; ++i) pf[i] = ssq[u.pm * BM + wr * 64 + fr + (i >> 2) * HALF + (i & 3) * 16]; }
    __device__ __forceinline__ void operator()(const f32x4 (&acc)[2][2][4][2], const Unit& u, int wr, int wc, int fr, int fq, const float (&pf)[8]) const {
        const int row0 = u.pm * BM + wr * 64 + fr, col0 = u.pn * HALF + wc * 32 + 8 * fq;
#pragma unroll
        for (int ai = 0; ai < 2; ++ai)
#pragma unroll
            for (int m = 0; m < 4; ++m) { const int row = row0 + ai * HALF + m * 16;
                const float r = __builtin_amdgcn_rsqf(pf[ai * 4 + m] * (1.0f / 1024.0f) + RMS_EPS);
                float h[8];
#pragma unroll
                for (int n = 0; n < 2; ++n)
#pragma unroll
                    for (int e = 0; e < 4; ++e) { const float g = acc[ai][0][m][n][e] * r, up = acc[ai][1][m][n][e] * r; h[4 * n + e] = silu_f(g) * up; }
                u32x4 w; w.x = cvt_pk_bf16(h[0], h[1]); w.y = cvt_pk_bf16(h[2], h[3]); w.z = cvt_pk_bf16(h[4], h[5]); w.w = cvt_pk_bf16(h[6], h[7]);
                *(u32x4*)(O + (size_t)row * ldc + col0) = w; }
    }
};
struct EpiResid {
    static constexpr bool PERM = true, AFTER_DRAIN = false;
    bf16_t* hb; float* ssq_out; float scale; int ldc;
    __device__ __forceinline__ void prefetch(const Unit&, int, int, int, int, float (&)[8]) const {}
    __device__ __forceinline__ void operator()(const f32x4 (&acc)[2][2][4][2], const Unit& u, int wr, int wc, int fr, int fq, const float (&pf)[8]) const {
        const int row0 = u.pm * BM + wr * 64 + fr, col0 = u.pn * BM + wc * 32 + 8 * fq;
#pragma unroll
        for (int ai = 0; ai < 2; ++ai)
#pragma unroll
            for (int m = 0; m < 4; ++m) { const int row = row0 + ai * HALF + m * 16; const size_t off = (size_t)row * ldc + col0; float s = 0.f;
                u32x4 bw[2];
#pragma unroll
                for (int bj = 0; bj < 2; ++bj) bw[bj] = *(const u32x4*)(hb + off + bj * HALF);
#pragma unroll
                for (int bj = 0; bj < 2; ++bj) {
                    const f32x4 b0 = (f32x4){__uint_as_float(bw[bj].x << 16), __uint_as_float(bw[bj].x & 0xffff0000u), __uint_as_float(bw[bj].y << 16), __uint_as_float(bw[bj].y & 0xffff0000u)};
                    const f32x4 b1 = (f32x4){__uint_as_float(bw[bj].z << 16), __uint_as_float(bw[bj].z & 0xffff0000u), __uint_as_float(bw[bj].w << 16), __uint_as_float(bw[bj].w & 0xffff0000u)};
                    const f32x4 v0 = b0 + acc[ai][bj][m][0] * scale, v1 = b1 + acc[ai][bj][m][1] * scale;
                    u32x4 w; w.x = cvt_pk_bf16(v0[0], v0[1]); w.y = cvt_pk_bf16(v0[2], v0[3]); w.z = cvt_pk_bf16(v1[0], v1[1]); w.w = cvt_pk_bf16(v1[2], v1[3]);
                    *(u32x4*)(hb + off + bj * HALF) = w;
                    s += (v0[0] * v0[0] + v0[1] * v0[1]) + (v0[2] * v0[2] + v0[3] * v0[3]) + (v1[0] * v1[0] + v1[1] * v1[1]) + (v1[2] * v1[2] + v1[3] * v1[3]); }
                s += __shfl_xor(s, 16); s += __shfl_xor(s, 32);
                if (fq == 0) unsafeAtomicAdd(ssq_out + row, s); }
    }
};
struct EpiProj {
    static constexpr bool PERM = true, AFTER_DRAIN = false;
    bf16_t* O; int ldc; const float* ssq; const float* omlb;
    __device__ __forceinline__ void prefetch(const Unit& u, int wr, int wc, int fr, int fq, float (&pf)[8]) const {
#pragma unroll
        for (int i = 0; i < 8; ++i) pf[i] = ssq[u.pm * BM + wr * 64 + fr + (i >> 2) * HALF + (i & 3) * 16]; }
    __device__ __forceinline__ void operator()(const f32x4 (&acc)[2][2][4][2], const Unit& u, int wr, int wc, int fr, int fq, const float (&pf)[8]) const {
        const int row0 = u.pm * BM + wr * 64 + fr, col0 = u.pn * BM + wc * 32 + 8 * fq; const int type = u.pn >> 1;
        float ol[2][8];
#pragma unroll
        for (int bj = 0; bj < 2; ++bj)
#pragma unroll
            for (int e = 0; e < 8; ++e) ol[bj][e] = (type == 3 || type == 4) ? omlb[col0 + bj * HALF + e - 1536] : 0.f;
#pragma unroll
        for (int ai = 0; ai < 2; ++ai)
#pragma unroll
            for (int m = 0; m < 4; ++m) { const int row = row0 + ai * HALF + m * 16;
                const float r = __builtin_amdgcn_rsqf(pf[ai * 4 + m] * (1.0f / 1024.0f) + RMS_EPS);
#pragma unroll
                for (int bj = 0; bj < 2; ++bj) { float h[8];
#pragma unroll
                    for (int n = 0; n < 2; ++n)
#pragma unroll
                        for (int e = 0; e < 4; ++e) { const float v = acc[ai][bj][m][n][e] * r; float o = v;
                            if (type == 1 || type == 5) o = silu_f(v);
                            if (type == 3 || type == 4) o = ol[bj][4 * n + e] * __builtin_amdgcn_rcpf(1.0f + __expf(v));
                            h[4 * n + e] = o; }
                    u32x4 w; w.x = cvt_pk_bf16(h[0], h[1]); w.y = cvt_pk_bf16(h[2], h[3]); w.z = cvt_pk_bf16(h[4], h[5]); w.w = cvt_pk_bf16(h[6], h[7]);
                    u32x4* dst = (u32x4*)(O + (size_t)row * ldc + col0 + bj * HALF);
                    if (type == 1 || type == 5) __builtin_nontemporal_store(w, dst); else *dst = w; } }
    }
};
struct EpiPlain {
    static constexpr bool PERM = true, AFTER_DRAIN = false;
    bf16_t* O; int ldc;
    __device__ __forceinline__ void prefetch(const Unit&, int, int, int, int, float (&)[8]) const {}
    __device__ __forceinline__ void operator()(const f32x4 (&acc)[2][2][4][2], const Unit& u, int wr, int wc, int fr, int fq, const float (&pf)[8]) const {
        const int row0 = u.pm * BM + wr * 64 + fr, col0 = u.pn * BM + wc * 32 + 8 * fq;
#pragma unroll
        for (int ai = 0; ai < 2; ++ai)
#pragma unroll
            for (int m = 0; m < 4; ++m) { const int row = row0 + ai * HALF + m * 16;
#pragma unroll
                for (int bj = 0; bj < 2; ++bj) { const f32x4 v0 = acc[ai][bj][m][0], v1 = acc[ai][bj][m][1];
                    u32x4 w; w.x = cvt_pk_bf16(v0[0], v0[1]); w.y = cvt_pk_bf16(v0[2], v0[3]); w.z = cvt_pk_bf16(v1[0], v1[1]); w.w = cvt_pk_bf16(v1[2], v1[3]);
                    *(u32x4*)(O + (size_t)row * ldc + col0 + bj * HALF) = w; } }
    }
};

template <class Epi, class Sched, bool ALIGN_EPI = false, bool SP2 = false>
__device__ __forceinline__ void gemm_phase(PG8_LAS unsigned char* lds, const Gemm g, const Sched& S, const Epi& E) {
    const int tid = threadIdx.x, wid = __builtin_amdgcn_readfirstlane(tid >> 6), lane = tid & 63, wr = wid >> 2, wc = wid & 3, fr = lane & 15, fq = lane >> 4;
    const int K = g.K, nt = K / BK;
    unsigned voffA[2], voffB[2];
#pragma unroll
    for (int i = 0; i < 2; ++i) { int R, C; stage_rc(tid * 16 + i * 8192, R, C); const int Rb = Epi::PERM ? ((R & ~31) + perm32(R & 31)) : R;
        voffA[i] = (unsigned)(R * K + C) * 2u; voffB[i] = (unsigned)(Rb * K + C) * 2u; }
    const size_t kstep = (size_t)(BK * 2);
    const size_t hstep = (size_t)HALF * K * 2;
    const size_t tstep = 2 * hstep;
    const unsigned ldsw = (unsigned)wid * 1024u;
    const int aoff = lds_byte(wr * 64 + fr, fq * 8), boff = lds_byte(wc * 32 + fr, fq * 8);
#define PG8_SA(b, h) (((b) * 2 + (h)) * HTB)
#define PG8_SB(b, h) ((4 + (b) * 2 + (h)) * HTB)
#define PG8_STAGE(bufoff, gbase, voff) do { _Pragma("unroll") for (int _i = 0; _i < 2; ++_i) \
        __builtin_amdgcn_global_load_lds((const unsigned*)((const char*)(gbase) + (voff)[_i]), (PG8_LAS unsigned*)(lds + (bufoff) + ldsw + _i * 8192), 16, 0, 0); } while (0)
#define PG8_LDA(dst, b, h) do { _Pragma("unroll") for (int m = 0; m < 4; ++m) _Pragma("unroll") for (int k = 0; k < 2; ++k) dst[m][k] = *(const PG8_LAS bf16x8*)(lds + PG8_SA(b, h) + aoff + m * 2048 + k * 1024); } while (0)
#define PG8_LDB(dst, b, h) do { _Pragma("unroll") for (int n = 0; n < 2; ++n) _Pragma("unroll") for (int k = 0; k < 2; ++k) dst[n][k] = *(const PG8_LAS bf16x8*)(lds + PG8_SB(b, h) + boff + n * 2048 + k * 1024); } while (0)
#define PG8_MMA(ai, bj, At, Bt) do { __builtin_amdgcn_s_setprio(1); _Pragma("unroll") for (int m = 0; m < 4; ++m) _Pragma("unroll") for (int n = 0; n < 2; ++n) _Pragma("unroll") for (int k = 0; k < 2; ++k) \
        acc[ai][bj][m][n] = __builtin_amdgcn_mfma_f32_16x16x32_bf16(Bt[n][k], At[m][k], acc[ai][bj][m][n], 0, 0, 0); __builtin_amdgcn_s_setprio(0); } while (0)
#define PG8_WAIT_V(n) asm volatile("s_waitcnt vmcnt(" #n ")" ::: "memory")
#define PG8_WAIT_L(n) asm volatile("s_waitcnt lgkmcnt(" #n ")" ::: "memory")
#define PG8_BAR __builtin_amdgcn_s_barrier()
#define PG8_SCHED __builtin_amdgcn_sched_barrier(0)
    Unit cur, nxt; int ui = 0;
    if (!S.next(0, cur)) return;
    f32x4 acc[2][2][4][2];
    float pf[8] = {0.f, 0.f, 0.f, 0.f, 0.f, 0.f, 0.f, 0.f};
#pragma unroll
    for (int a = 0; a < 2; ++a)
#pragma unroll
        for (int b = 0; b < 2; ++b)
#pragma unroll
            for (int m = 0; m < 4; ++m)
#pragma unroll
                for (int n = 0; n < 2; ++n) acc[a][b][m][n] = (f32x4){0.f, 0.f, 0.f, 0.f};
    bf16x8 At[4][2], B0[2][2], B1[2][2];
    const char* cA = (const char*)g.A + (size_t)cur.pm * tstep; const char* cB = (const char*)g.Bt + (size_t)cur.pn * tstep;
    S.a_ready(cur);
    if constexpr (SP2) {
        PG8_STAGE(PG8_SB(0, 0), cB, voffB); PG8_STAGE(PG8_SB(0, 1), cB + hstep, voffB); PG8_STAGE(PG8_SA(0, 0), cA, voffA); PG8_STAGE(PG8_SA(0, 1), cA + hstep, voffA);
        if (wr == 1) PG8_BAR;
        PG8_WAIT_V(2); PG8_BAR;
        PG8_STAGE(PG8_SB(1, 0), cB + kstep, voffB); PG8_STAGE(PG8_SA(1, 0), cA + kstep, voffA); PG8_STAGE(PG8_SB(1, 1), cB + hstep + kstep, voffB);
        PG8_WAIT_V(6); PG8_BAR;
    } else {
        PG8_STAGE(PG8_SB(0, 0), cB, voffB); PG8_STAGE(PG8_SA(0, 0), cA, voffA); PG8_STAGE(PG8_SB(0, 1), cB + hstep, voffB); PG8_STAGE(PG8_SA(0, 1), cA + hstep, voffA);
        if (wr == 1) PG8_BAR;
        PG8_WAIT_V(4); PG8_BAR;
        PG8_STAGE(PG8_SB(1, 0), cB + kstep, voffB); PG8_STAGE(PG8_SA(1, 0), cA + kstep, voffA); PG8_STAGE(PG8_SB(1, 1), cB + hstep + kstep, voffB);
        PG8_WAIT_V(6); PG8_BAR;
    }
    for (;;) {
        const bool has_next = S.next(ui + 1, nxt);
        const char* nA = has_next ? (const char*)g.A + (size_t)nxt.pm * tstep : cA; const char* nB = has_next ? (const char*)g.Bt + (size_t)nxt.pn * tstep : cB;
        for (int t = 0; t < nt; t += 2) {
            const bool last = (t == nt - 2);
            const char* a1 = cA + (size_t)(t + 1) * kstep;
            const char* a2 = last ? nA : cA + (size_t)(t + 2) * kstep; const char* b2 = last ? nB : cB + (size_t)(t + 2) * kstep;
            const char* a3 = a2 + kstep; const char* b3 = b2 + kstep;
            if (last && has_next) S.a_ready(nxt);
            if (last) E.prefetch(cur, wr, wc, fr, fq, pf);
            if constexpr (SP2) {
            PG8_LDB(B0, 0, 0); PG8_LDB(B1, 0, 1); PG8_SCHED; PG8_LDA(At, 0, 0); PG8_STAGE(PG8_SA(1, 1), a1 + hstep, voffA);
            PG8_WAIT_V(8); PG8_WAIT_L(0); PG8_BAR; PG8_MMA(0, 0, At, B0); PG8_MMA(0, 1, At, B1); PG8_BAR; PG8_SCHED;
            PG8_LDA(At, 0, 1); PG8_STAGE(PG8_SB(0, 0), b2, voffB); PG8_STAGE(PG8_SB(0, 1), b2 + hstep, voffB); PG8_STAGE(PG8_SA(0, 0), a2, voffA);
            PG8_WAIT_V(8); PG8_WAIT_L(0); PG8_BAR; PG8_MMA(1, 0, At, B0); PG8_MMA(1, 1, At, B1); PG8_BAR; PG8_SCHED;
            PG8_LDB(B0, 1, 0); PG8_LDB(B1, 1, 1); PG8_SCHED; PG8_LDA(At, 1, 0); PG8_STAGE(PG8_SA(0, 1), a2 + hstep, voffA);
            PG8_WAIT_V(8); PG8_WAIT_L(0); PG8_BAR; PG8_MMA(0, 0, At, B0); PG8_MMA(0, 1, At, B1); PG8_BAR; PG8_SCHED;
            PG8_LDA(At, 1, 1); PG8_STAGE(PG8_SB(1, 0), b3, voffB); PG8_STAGE(PG8_SB(1, 1), b3 + hstep, voffB); PG8_STAGE(PG8_SA(1, 0), a3, voffA);
            PG8_WAIT_V(8); PG8_WAIT_L(0); PG8_BAR; PG8_MMA(1, 0, At, B0); PG8_MMA(1, 1, At, B1); PG8_BAR; PG8_SCHED;
            } else {
            PG8_LDB(B0, 0, 0); PG8_SCHED; PG8_LDA(At, 0, 0); PG8_STAGE(PG8_SA(1, 1), a1 + hstep, voffA);
            PG8_WAIT_L(8); PG8_BAR; PG8_WAIT_L(0); PG8_MMA(0, 0, At, B0); PG8_BAR; PG8_SCHED;
            PG8_LDB(B1, 0, 1); PG8_STAGE(PG8_SB(0, 0), b2, voffB);
            PG8_BAR; PG8_WAIT_L(0); PG8_MMA(0, 1, At, B1); PG8_BAR;
            PG8_LDA(At, 0, 1); PG8_STAGE(PG8_SA(0, 0), a2, voffA);
            PG8_BAR; PG8_WAIT_L(0); PG8_MMA(1, 0, At, B0); PG8_BAR; PG8_SCHED;
            PG8_STAGE(PG8_SB(0, 1), b2 + hstep, voffB);
            PG8_WAIT_V(6); PG8_BAR; PG8_MMA(1, 1, At, B1); PG8_BAR;
            PG8_LDB(B0, 1, 0); PG8_SCHED; PG8_LDA(At, 1, 0); PG8_STAGE(PG8_SA(0, 1), a2 + hstep, voffA);
            PG8_WAIT_L(8); PG8_BAR; PG8_WAIT_L(0); PG8_MMA(0, 0, At, B0); PG8_BAR; PG8_SCHED;
            PG8_LDB(B1, 1, 1); PG8_STAGE(PG8_SB(1, 0), b3, voffB);
            PG8_BAR; PG8_WAIT_L(0); PG8_MMA(0, 1, At, B1); PG8_BAR;
            PG8_LDA(At, 1, 1); PG8_STAGE(PG8_SA(1, 0), a3, voffA);
            PG8_BAR; PG8_WAIT_L(0); PG8_MMA(1, 0, At, B0); PG8_BAR; PG8_SCHED;
            PG8_STAGE(PG8_SB(1, 1), b3 + hstep, voffB);
            PG8_WAIT_V(6); PG8_BAR; PG8_MMA(1, 1, At, B1); PG8_BAR;
            }
        }
        if constexpr (ALIGN_EPI) { if (wr == 0) PG8_BAR; }
        if constexpr (!Epi::AFTER_DRAIN) { E(acc, cur, wr, wc, fr, fq, pf); S.done(cur); }
        if (!has_next) break;
#pragma unroll
        for (int a = 0; a < 2; ++a)
#pragma unroll
            for (int b = 0; b < 2; ++b)
#pragma unroll
                for (int m = 0; m < 4; ++m)
#pragma unroll
                    for (int n = 0; n < 2; ++n) acc[a][b][m][n] = (f32x4){0.f, 0.f, 0.f, 0.f};
        cur = nxt; cA = nA; cB = nB; ++ui;
        if constexpr (ALIGN_EPI) { if (wr == 1) PG8_BAR; }
    }
    PG8_WAIT_V(0);
    if constexpr (!ALIGN_EPI) { if (wr == 0) PG8_BAR; }
    PG8_BAR;
    if constexpr (Epi::AFTER_DRAIN) { E.fused(acc, cur, wr, wc, fr, fq, lds, wid, lane); S.done(cur); }
#undef PG8_SA
#undef PG8_SB
#undef PG8_STAGE
#undef PG8_LDA
#undef PG8_LDB
#undef PG8_MMA
#undef PG8_WAIT_V
#undef PG8_WAIT_L
#undef PG8_BAR
#undef PG8_SCHED
}
}

constexpr int NWAVES = 8;
constexpr int BATCH = 8, SEQ = 8192, D = 1024, FF = 2816, INC = 3072, PW = 512, HW = 512, HD = 128;
constexpr int M = BATCH * SEQ;
constexpr float EPS = 1e-6f;
constexpr size_t MiB = 1u << 20;
constexpr size_t WS_SSQ = 0;
constexpr size_t WS_BAR = 1 * MiB + 512 * 1024;
constexpr size_t WS_OMLB = 1 * MiB;
constexpr size_t WS_WGU1 = 2 * MiB;
constexpr size_t WS_WD1 = 13 * MiB;
constexpr size_t WS_WIN = 19 * MiB;
constexpr size_t WS_WOUT = 25 * MiB;
constexpr size_t WS_WGU2 = 27 * MiB;
constexpr size_t WS_WD2 = 38 * MiB;
constexpr size_t WS_WPOOL = 44 * MiB;
constexpr size_t WS_ACTB = 48 * MiB;
constexpr size_t WS_YMIX = 176 * MiB;
constexpr size_t WS_PROJ = 304 * MiB;
constexpr size_t WS_LT = 688 * MiB;
constexpr size_t WS_POOLED = 944 * MiB;
constexpr size_t WS_END = 1008 * MiB;
constexpr int LDS_BYTES = 147456;

#define LAS __attribute__((address_space(3)))
typedef unsigned short bf16;
typedef unsigned v4u __attribute__((ext_vector_type(4)));
typedef unsigned v2u __attribute__((ext_vector_type(2)));
typedef float f32x4 __attribute__((ext_vector_type(4)));
typedef float f32x2 __attribute__((ext_vector_type(2)));
#define LDS_WAIT() asm volatile("s_waitcnt lgkmcnt(0)" ::: "memory")
__device__ __forceinline__ unsigned pk2(float lo, float hi) { return pg8::cvt_pk_bf16(lo, hi); }
__device__ __forceinline__ float bflo(unsigned w) { return __uint_as_float(w << 16); }
__device__ __forceinline__ float bfhi(unsigned w) { return __uint_as_float(w & 0xffff0000u); }
__device__ __forceinline__ float wave_sum(float v) {
#pragma unroll
    for (int o = 1; o < 64; o <<= 1) v += __shfl_xor(v, o);
    return v;
}

__device__ __forceinline__ void transpose_item(const float* W, int N, bf16* WT, int ldk, int koff, int mode, int rowoff, const float* ks, const float* ns, LAS float* scr, int item, int lane) {
    const int nblk = N / 32, kb = item / nblk, nb = item % nblk, k0 = 64 * kb, n0 = 32 * nb;
#pragma unroll
    for (int i = 0; i < 32; ++i) { const int kk = 2 * i + (lane >> 5); float w = __builtin_nontemporal_load(W + (size_t)(k0 + kk) * N + n0 + (lane & 31)); if (ks) w *= ks[k0 + kk]; scr[kk * 33 + (lane & 31)] = w; }
    LDS_WAIT(); asm volatile("" ::: "memory");
    const int c = lane & 7;
#pragma unroll
    for (int j = 0; j < 4; ++j) { const int n = (lane >> 3) + 8 * j; const LAS float* s = scr + (8 * c) * 33 + n; const float sc = ns ? ns[n0 + n] : 1.0f;
        v4u o; o.x = pk2(s[0 * 33] * sc, s[1 * 33] * sc); o.y = pk2(s[2 * 33] * sc, s[3 * 33] * sc); o.z = pk2(s[4 * 33] * sc, s[5 * 33] * sc); o.w = pk2(s[6 * 33] * sc, s[7 * 33] * sc);
        const int ng = n0 + n; const int drow = (mode == 1) ? (256 * (ng >> 7) + rowoff + (ng & 127)) : (rowoff + ng);
        *(v4u*)(WT + (size_t)drow * ldk + koff + k0 + 8 * c) = o; }
    LDS_WAIT(); asm volatile("" ::: "memory");
}

#define XB_TMO      128
#define XB_XCNT(j)  (256  + 64 * (j))
#define XB_XSUB(j)  (1280 + 64 * (j))
#define XB_XGEN(j)  (2304 + 64 * (j))
#define XB_TOP      3328
#define XB_TOPGEN   3392
#define XCD_BAR_WORDS 3456
#define XB_SPIN_CAP (1u << 18)

__device__ __forceinline__ unsigned xb_ld(unsigned* p)              { return __hip_atomic_load(p, __ATOMIC_RELAXED, __HIP_MEMORY_SCOPE_AGENT); }
__device__ __forceinline__ unsigned xb_add(unsigned* p, unsigned v) { return __hip_atomic_fetch_add(p, v, __ATOMIC_RELAXED, __HIP_MEMORY_SCOPE_AGENT); }
__device__ __forceinline__ unsigned xb_xcc_id() { return (unsigned)__builtin_amdgcn_s_getreg((3 << 11) | 20) & 0xFu; }
#define XB_SPIN(cond, bar) do { unsigned _sp = 0; while (cond) { __builtin_amdgcn_s_sleep(1); \
    if ((++_sp & 255u) == 0u) { if (xb_ld(&(bar)[XB_TMO])) break; if (_sp > XB_SPIN_CAP) { atomicAdd(&(bar)[XB_TMO], 1u); break; } } } } while (0)

struct XcdBarrier {
    unsigned* bar; unsigned x;
    volatile LAS unsigned* st;
};

__device__ __forceinline__ XcdBarrier xcd_barrier_post(unsigned* bar, volatile LAS unsigned* st) {
    XcdBarrier b; b.bar = bar; b.x = xb_xcc_id(); b.st = st;
    if (threadIdx.x == 0) (void)xb_add(&bar[XB_XCNT(b.x)], 1u);
    return b;
}
__device__ __forceinline__ void xcd_barrier_complete(unsigned* bar, unsigned x, unsigned& nloc, unsigned& nx) {
    const unsigned G = gridDim.x * gridDim.y * gridDim.z;
    unsigned sum, cnt, mine, sp = 0u;
    for (;;) {
        sum = 0u; cnt = 0u; mine = 0u;
#pragma unroll
        for (unsigned j = 0; j < 16; ++j) { const unsigned c = xb_ld(&bar[XB_XCNT(j)]); sum += c; cnt += (c > 0u) ? 1u : 0u; mine = (j == x) ? c : mine; }
        if (sum == G) break;
        __builtin_amdgcn_s_sleep(1);
        if ((++sp & 255u) == 0u) { if (xb_ld(&bar[XB_TMO])) break; if (sp > XB_SPIN_CAP) { atomicAdd(&bar[XB_TMO], 1u); break; } }
    }
    nloc = mine > 0u ? mine : 1u; nx = cnt > 0u ? cnt : 1u;
}

__device__ __forceinline__ void xcd_barrier(const XcdBarrier& b) {
    asm volatile("s_waitcnt vmcnt(0)" ::: "memory");
    __syncthreads();
    if (threadIdx.x == 0) {
        unsigned* bar = b.bar;
        __builtin_amdgcn_s_waitcnt(0);
        unsigned nloc = b.st[0], nx = b.st[1];
        if (nloc == 0u) { xcd_barrier_complete(bar, b.x, nloc, nx); b.st[0] = nloc; b.st[1] = nx; }
        const unsigned old = xb_add(&bar[XB_XSUB(b.x)], 1u);
        const unsigned gen = old / nloc;
        if (old + 1u == (gen + 1u) * nloc) {
            __builtin_amdgcn_fence(__ATOMIC_RELEASE, "agent");
            asm volatile("s_waitcnt vmcnt(0)" ::: "memory");
            const unsigned og = xb_add(&bar[XB_TOP], 1u);
            const unsigned tg = og / nx;
            if (og + 1u == (tg + 1u) * nx) xb_add(&bar[XB_TOPGEN], 1u);
            else XB_SPIN(xb_ld(&bar[XB_TOPGEN]) == tg, bar);
            __builtin_amdgcn_fence(__ATOMIC_ACQUIRE, "agent");
            xb_add(&bar[XB_XGEN(b.x)], 1u);
            asm volatile("s_waitcnt vmcnt(0)" ::: "memory");
        } else {
            XB_SPIN(xb_ld(&bar[XB_XGEN(b.x)]) == gen, bar);
            __builtin_amdgcn_fence(__ATOMIC_ACQUIRE, "agent");
            asm volatile("s_waitcnt vmcnt(0)" ::: "memory");
        }
    }
    __syncthreads();
}

struct Args { const float* in[17]; float* out; unsigned char* ws; };

__device__ __forceinline__ void p0_prologue(const Args& a, LAS unsigned char* lds, int gw, int NGW, int wave, int lane) {
    unsigned char* ws = a.ws;
    LAS float* scr = (LAS float*)(lds + wave * 16384);
    constexpr int I_GU = (D / 64) * (FF / 32), I_DN = (FF / 64) * (D / 32), I_IN = (D / 64) * (INC / 32), I_OUT = (HW / 64) * (D / 32);
    constexpr int NITEMS = 4 * I_GU + 2 * I_DN + I_IN + I_OUT;
    for (int it = gw; it < NITEMS; it += NGW) {
        int r = it;
        if (r < I_GU) { transpose_item(a.in[2], FF, (bf16*)(ws + WS_WGU1), D, 0, 1, 0, a.in[1], nullptr, scr, r, lane); continue; } r -= I_GU;
        if (r < I_GU) { transpose_item(a.in[3], FF, (bf16*)(ws + WS_WGU1), D, 0, 1, 128, a.in[1], nullptr, scr, r, lane); continue; } r -= I_GU;
        if (r < I_GU) { transpose_item(a.in[13], FF, (bf16*)(ws + WS_WGU2), D, 0, 1, 0, a.in[12], nullptr, scr, r, lane); continue; } r -= I_GU;
        if (r < I_GU) { transpose_item(a.in[14], FF, (bf16*)(ws + WS_WGU2), D, 0, 1, 128, a.in[12], nullptr, scr, r, lane); continue; } r -= I_GU;
        if (r < I_DN) { transpose_item(a.in[4], D, (bf16*)(ws + WS_WD1), FF, 0, 0, 0, nullptr, nullptr, scr, r, lane); continue; } r -= I_DN;
        if (r < I_DN) { transpose_item(a.in[15], D, (bf16*)(ws + WS_WD2), FF, 0, 0, 0, nullptr, nullptr, scr, r, lane); continue; } r -= I_DN;
        if (r < I_IN) { transpose_item(a.in[6], INC, (bf16*)(ws + WS_WIN), D, 0, 0, 0, a.in[5], nullptr, scr, r, lane); continue; } r -= I_IN;
        transpose_item(a.in[11], D, (bf16*)(ws + WS_WOUT), D, 0, 0, 0, nullptr, nullptr, scr, r + (PW / 64) * (D / 32), lane);
    }
    for (int wi = gw; wi < 2048; wi += NGW) {
        const int n = (wi & 15) * 64 + lane, kq = wi >> 4, g = kq >> 5, c0 = (kq & 31) * 4;
        const float* wo = a.in[11] + (size_t)(g * 128) * D + n; const float* pw = a.in[7] + (size_t)(g * 128 + c0) * 128; const float* ps = a.in[8] + g * 128;
        f32x4 acc4 = (f32x4){0.f, 0.f, 0.f, 0.f};
#pragma unroll 8
        for (int d = 0; d < 128; d += 4) {
            const f32x4 p4 = *(const f32x4*)(ps + d);
            const f32x4 w4 = (f32x4){wo[(size_t)d * D], wo[(size_t)(d + 1) * D], wo[(size_t)(d + 2) * D], wo[(size_t)(d + 3) * D]} * p4;
#pragma unroll
            for (int e = 0; e < 4; ++e) { const f32x4 q4 = *(const f32x4*)(pw + e * 128 + d); acc4[e] += (w4[0] * q4[0] + w4[1] * q4[1]) + (w4[2] * q4[2] + w4[3] * q4[3]); } }
        *(v2u*)((bf16*)(ws + WS_WOUT) + (size_t)n * D + kq * 4) = (v2u){pk2(acc4[0], acc4[1]), pk2(acc4[2], acc4[3])};
    }
    const float* x = a.in[0]; bf16* xb = (bf16*)(ws + WS_ACTB); float* ssq = (float*)(ws + WS_SSQ);
    for (int m = gw; m < M; m += NGW) {
        const f32x4* xr = (const f32x4*)(x + (size_t)m * D) + lane; f32x4 v[4]; float s = 0.f;
#pragma unroll
        for (int j = 0; j < 4; ++j) { v[j] = __builtin_nontemporal_load(xr + 64 * j); s += (v[j].x * v[j].x + v[j].y * v[j].y) + (v[j].z * v[j].z + v[j].w * v[j].w); }
        s = wave_sum(s);
        v2u* o8 = (v2u*)(xb + (size_t)m * D) + lane;
#pragma unroll
        for (int j = 0; j < 4; ++j) o8[64 * j] = (v2u){pk2(v[j].x, v[j].y), pk2(v[j].z, v[j].w)};
        if (lane == 0) { ssq[m] = s; ssq[M + m] = 0.f; ssq[2 * M + m] = 0.f; ssq[3 * M + m] = 0.f; }
    }
    if (gw < 16) { const int i = gw * 64 + lane; const int d = i >> 9, w = i & 511; const float a0 = a.in[9][d * 1024 + w], a1 = a.in[9][d * 1024 + 512 + w];
        ((float*)(ws + WS_OMLB))[i] = 1.0f / (1.0f + expf(a0 - a1)); }
}

__device__ __forceinline__ void pool_rows(const bf16* proj, bf16* pooled, int gw, int NGW, int lane) {
    const int g = lane >> 4, half = 1 << g;
    float mul[16];
#pragma unroll
    for (int d = 0; d < 16; ++d) mul[d] = (d - 8 >= -half && d - 8 < half) ? 1.0f : 0.0f;
    for (int blk = gw; blk < M / 8; blk += NGW) {
        const int m0 = blk * 8, t0 = m0 & (SEQ - 1);
        const bf16* base = proj + (size_t)(m0 - t0) * INC + lane * 8;
        v4u z[24];
#pragma unroll
        for (int j = 0; j < 24; ++j) { const int t = t0 - 8 + j; z[j] = (t >= 0 && t < SEQ) ? __builtin_nontemporal_load((const v4u*)(base + (size_t)t * INC)) : (v4u){0u, 0u, 0u, 0u}; }
#pragma unroll
        for (int r = 0; r < 8; ++r) {
            float s[8];
#pragma unroll
            for (int e = 0; e < 8; ++e) s[e] = 0.f;
#pragma unroll
            for (int d = 0; d < 16; ++d) { const v4u w = z[r + d]; const float ml = mul[d];
                s[0] += ml * bflo(w.x); s[1] += ml * bfhi(w.x); s[2] += ml * bflo(w.y); s[3] += ml * bfhi(w.y); s[4] += ml * bflo(w.z); s[5] += ml * bfhi(w.z); s[6] += ml * bflo(w.w); s[7] += ml * bfhi(w.w); }
            const int t = t0 + r; const int lo = (t - half) < 0 ? 0 : (t - half), hi = (t + half) > SEQ ? SEQ : (t + half);
            const float inv = 1.0f / (float)(hi - lo); const v4u zc = z[r + 8];
            v4u o; o.x = pk2(s[0] * inv - bflo(zc.x), s[1] * inv - bfhi(zc.x)); o.y = pk2(s[2] * inv - bflo(zc.y), s[3] * inv - bfhi(zc.y));
            o.z = pk2(s[4] * inv - bflo(zc.z), s[5] * inv - bfhi(zc.z)); o.w = pk2(s[6] * inv - bflo(zc.w), s[7] * inv - bfhi(zc.w));
            __builtin_nontemporal_store(o, (v4u*)(pooled + (size_t)(m0 + r) * D + lane * 8));
        }
    }
}

typedef short bf16x8 __attribute__((ext_vector_type(8)));
__device__ __forceinline__ f32x4 mfma16(bf16x8 x, bf16x8 y, f32x4 c) { return __builtin_amdgcn_mfma_f32_16x16x32_bf16(x, y, c, 0, 0, 0); }
constexpr int TR_STRIDE = 144;
constexpr int CH_STRIDE = 272;

__device__ __forceinline__ float fast_ln(float x) { return __builtin_amdgcn_logf(x) * 0.69314718f; }
constexpr float ST_SCALE = 8.0f, ST_INV = 1.0f / 8.0f, ST_MAX = 440.0f;
__device__ __forceinline__ float st_clamp(float x) { return fminf(fmaxf(x, -ST_MAX), ST_MAX); }
__device__ __forceinline__ unsigned pack_fp8x4(float a, float b, float c, float d) {
    int w = 0; w = __builtin_amdgcn_cvt_pk_fp8_f32(st_clamp(a), st_clamp(b), w, false); w = __builtin_amdgcn_cvt_pk_fp8_f32(st_clamp(c), st_clamp(d), w, true); return (unsigned)w; }
__device__ __forceinline__ f32x4 unpack_fp8x4(unsigned w) { const f32x2 lo = __builtin_amdgcn_cvt_pk_f32_fp8((int)w, false), hi = __builtin_amdgcn_cvt_pk_f32_fp8((int)w, true); return (f32x4){lo.x, lo.y, hi.x, hi.y}; }

struct HlP { unsigned rv[8], rkf[8], rkb[8]; };
__device__ __forceinline__ void hgrn_local_loadp(const bf16* proj, int it, int tid, HlP& P) {
    const int b = it >> 9, head = (it >> 7) & 3, c = it & 127, cp = tid & 63, pg = __builtin_amdgcn_readfirstlane(tid >> 6);
    const bf16* pv = proj + ((size_t)b * SEQ + c * 64 + pg * 8) * INC + 1024 + head * 128 + 2 * cp;
#pragma unroll
    for (int i = 0; i < 8; ++i) { P.rv[i] = __builtin_nontemporal_load((const unsigned*)(pv + (size_t)i * INC)); P.rkf[i] = __builtin_nontemporal_load((const unsigned*)(pv + (size_t)i * INC + 512)); P.rkb[i] = __builtin_nontemporal_load((const unsigned*)(pv + (size_t)i * INC + 1024)); }
}
__device__ __forceinline__ void hgrn_local_item(const bf16* proj, bf16* LT, float* DV, LAS unsigned char* lds, int it, int tid, const HlP& R, int it_next, HlP& NX) {
    const int b = it >> 9, head = (it >> 7) & 3, c = it & 127;
    const int cp = tid & 63, pg = __builtin_amdgcn_readfirstlane(tid >> 6), lane = tid & 63, fr = lane & 15, fq = lane >> 4;
    LAS unsigned char* VT = lds;
    LAS unsigned char* KF = lds + 128 * TR_STRIDE;
    LAS unsigned char* KB = lds + 2 * 128 * TR_STRIDE;
    LAS float* TF = (LAS float*)(lds + 3 * 128 * TR_STRIDE);
    LAS float* TB = TF + 1024;
    float gf[8][2], gb[8][2]; float tf0 = 0.f, tf1 = 0.f, tb0 = 0.f, tb1 = 0.f;
#pragma unroll
    for (int i = 0; i < 8; ++i) { gf[i][0] = fast_ln(1.0f - bflo(R.rkf[i])); gf[i][1] = fast_ln(1.0f - bfhi(R.rkf[i])); gb[i][0] = fast_ln(1.0f - bflo(R.rkb[i])); gb[i][1] = fast_ln(1.0f - bfhi(R.rkb[i]));
        tf0 += gf[i][0]; tf1 += gf[i][1]; tb0 += gb[i][0]; tb1 += gb[i][1]; }
    *(LAS f32x2*)(TF + pg * 128 + 2 * cp) = (f32x2){tf0, tf1}; *(LAS f32x2*)(TB + pg * 128 + 2 * cp) = (f32x2){tb0, tb1};
    { v4u w0, w1;
      w0.x = (R.rv[0] & 0xffffu) | (R.rv[1] << 16); w0.y = (R.rv[2] & 0xffffu) | (R.rv[3] << 16); w0.z = (R.rv[4] & 0xffffu) | (R.rv[5] << 16); w0.w = (R.rv[6] & 0xffffu) | (R.rv[7] << 16);
      w1.x = (R.rv[0] >> 16) | (R.rv[1] & 0xffff0000u); w1.y = (R.rv[2] >> 16) | (R.rv[3] & 0xffff0000u); w1.z = (R.rv[4] >> 16) | (R.rv[5] & 0xffff0000u); w1.w = (R.rv[6] >> 16) | (R.rv[7] & 0xffff0000u);
      *(LAS v4u*)(VT + (2 * cp) * TR_STRIDE + pg * 16) = w0; *(LAS v4u*)(VT + (2 * cp + 1) * TR_STRIDE + pg * 16) = w1; }
    __syncthreads();
    if (it_next >= 0) hgrn_local_loadp(proj, it_next, tid, NX);
    float af0 = 0.f, af1 = 0.f, bb0 = 0.f, bb1 = 0.f, sf0 = 0.f, sf1 = 0.f, sb0 = 0.f, sb1 = 0.f;
#pragma unroll
    for (int p = 0; p < 8; ++p) { const f32x2 a = *(const LAS f32x2*)(TF + p * 128 + 2 * cp), bq = *(const LAS f32x2*)(TB + p * 128 + 2 * cp);
        sf0 += a.x; sf1 += a.y; sb0 += bq.x; sb1 += bq.y; if (p > pg) { af0 += a.x; af1 += a.y; } if (p < pg) { bb0 += bq.x; bb1 += bq.y; } }
    const int seqf = (b * 4 + head) * 128 + c, seqb = ((32 + b * 4 + head)) * 128 + c;
    if (pg == 0) { *(f32x2*)(DV + (size_t)seqf * 128 + 2 * cp) = (f32x2){__expf(sf0), __expf(sf1)}; *(f32x2*)(DV + (size_t)seqb * 128 + 2 * cp) = (f32x2){__expf(sb0), __expf(sb1)}; }
    { float kd[8][2];
#pragma unroll
      for (int i = 7; i >= 0; --i) { kd[i][0] = bflo(R.rkf[i]) * __expf(af0); kd[i][1] = bfhi(R.rkf[i]) * __expf(af1); af0 += gf[i][0]; af1 += gf[i][1]; }
      v4u w0, w1; w0.x = pk2(kd[0][0], kd[1][0]); w0.y = pk2(kd[2][0], kd[3][0]); w0.z = pk2(kd[4][0], kd[5][0]); w0.w = pk2(kd[6][0], kd[7][0]);
      w1.x = pk2(kd[0][1], kd[1][1]); w1.y = pk2(kd[2][1], kd[3][1]); w1.z = pk2(kd[4][1], kd[5][1]); w1.w = pk2(kd[6][1], kd[7][1]);
      *(LAS v4u*)(KF + (2 * cp) * TR_STRIDE + pg * 16) = w0; *(LAS v4u*)(KF + (2 * cp + 1) * TR_STRIDE + pg * 16) = w1;
#pragma unroll
      for (int i = 0; i < 8; ++i) { kd[i][0] = bflo(R.rkb[i]) * __expf(bb0); kd[i][1] = bfhi(R.rkb[i]) * __expf(bb1); bb0 += gb[i][0]; bb1 += gb[i][1]; }
      w0.x = pk2(kd[0][0], kd[1][0]); w0.y = pk2(kd[2][0], kd[3][0]); w0.z = pk2(kd[4][0], kd[5][0]); w0.w = pk2(kd[6][0], kd[7][0]);
      w1.x = pk2(kd[0][1], kd[1][1]); w1.y = pk2(kd[2][1], kd[3][1]); w1.z = pk2(kd[4][1], kd[5][1]); w1.w = pk2(kd[6][1], kd[7][1]);
      *(LAS v4u*)(KB + (2 * cp) * TR_STRIDE + pg * 16) = w0; *(LAS v4u*)(KB + (2 * cp + 1) * TR_STRIDE + pg * 16) = w1; }
    __syncthreads();
    { const int dir = pg >> 2, tv0 = 2 * (pg & 3); const LAS unsigned char* KD = dir ? KB : KF;
      unsigned char* out = (unsigned char*)LT + (size_t)(dir ? seqb : seqf) * 16384;
      bf16x8 y0[2], y1[2];
#pragma unroll
      for (int ks = 0; ks < 2; ++ks) { y0[ks] = *(const LAS bf16x8*)(VT + (16 * tv0 + fr) * TR_STRIDE + (32 * ks + 8 * fq) * 2); y1[ks] = *(const LAS bf16x8*)(VT + (16 * tv0 + 16 + fr) * TR_STRIDE + (32 * ks + 8 * fq) * 2); }
#pragma unroll
      for (int tk = 0; tk < 8; ++tk) { f32x4 a0 = (f32x4){0.f, 0.f, 0.f, 0.f}, a1 = a0;
#pragma unroll
          for (int ks = 0; ks < 2; ++ks) { const bf16x8 x = *(const LAS bf16x8*)(KD + (16 * tk + fr) * TR_STRIDE + (32 * ks + 8 * fq) * 2); a0 = mfma16(x, y0[ks], a0); a1 = mfma16(x, y1[ks], a1); }
          *(unsigned*)(out + (size_t)(16 * tv0 + fr) * 128 + 16 * tk + 4 * fq) = pack_fp8x4(a0[0] * ST_SCALE, a0[1] * ST_SCALE, a0[2] * ST_SCALE, a0[3] * ST_SCALE);
          *(unsigned*)(out + (size_t)(16 * tv0 + 16 + fr) * 128 + 16 * tk + 4 * fq) = pack_fp8x4(a1[0] * ST_SCALE, a1[1] * ST_SCALE, a1[2] * ST_SCALE, a1[3] * ST_SCALE); } }
    __syncthreads();
}

__device__ __forceinline__ void hgrn_state_scan(bf16* LT, const float* DV, int T, int NT) {
    for (int x = T; x < 64 * 2048; x += NT) {
        const int seqi = x >> 11, e8 = x & 2047, dir = seqi >> 5, k0 = (e8 & 15) * 8;
        unsigned char* base = (unsigned char*)LT + (size_t)seqi * 128 * 16384 + e8 * 8; const float* dbase = DV + (size_t)seqi * 128 * 128 + k0;
        f32x4 S0 = (f32x4){0.f, 0.f, 0.f, 0.f}, S1 = S0;
        for (int cc = 0; cc < 128; cc += 8) {
            v2u L[8]; f32x4 d0[8], d1[8];
#pragma unroll
            for (int j = 0; j < 8; ++j) { const int c = dir ? (127 - cc - j) : (cc + j); L[j] = __builtin_nontemporal_load((const v2u*)(base + (size_t)c * 16384)); d0[j] = *(const f32x4*)(dbase + c * 128); d1[j] = *(const f32x4*)(dbase + c * 128 + 4); }
#pragma unroll
            for (int j = 0; j < 8; ++j) { const int c = dir ? (127 - cc - j) : (cc + j);
                *(v2u*)(base + (size_t)c * 16384) = (v2u){pack_fp8x4(S0[0], S0[1], S0[2], S0[3]), pack_fp8x4(S1[0], S1[1], S1[2], S1[3])};
                S0 = d0[j] * S0 + unpack_fp8x4(L[j].x); S1 = d1[j] * S1 + unpack_fp8x4(L[j].y); }
        }
    }
}

__device__ __forceinline__ bf16x8 frag_fp8(const LAS unsigned char* p) {
    const v2u w = *(const LAS v2u*)p; const f32x4 a = unpack_fp8x4(w.x), c = unpack_fp8x4(w.y);
    return __builtin_bit_cast(bf16x8, (v4u){pk2(a[0], a[1]), pk2(a[2], a[3]), pk2(c[0], c[1]), pk2(c[2], c[3])});
}
struct HoP { unsigned rq[8], rv[8], rkf[8], rkb[8]; v4u rawS[2][2]; };
__device__ __forceinline__ void hgrn_out_loadp(const bf16* proj, const bf16* LT, int it, int tid, HoP& P) {
    const int b = it >> 9, head = (it >> 7) & 3, c = it & 127, cp = tid & 63, pg = __builtin_amdgcn_readfirstlane(tid >> 6);
    const bf16* pq = proj + ((size_t)b * SEQ + c * 64 + pg * 8) * INC + 512 + head * 128 + 2 * cp;
#pragma unroll
    for (int i = 0; i < 8; ++i) { P.rq[i] = __builtin_nontemporal_load((const unsigned*)(pq + (size_t)i * INC)); P.rv[i] = __builtin_nontemporal_load((const unsigned*)(pq + (size_t)i * INC + 512));
        P.rkf[i] = __builtin_nontemporal_load((const unsigned*)(pq + (size_t)i * INC + 1024)); P.rkb[i] = __builtin_nontemporal_load((const unsigned*)(pq + (size_t)i * INC + 1536)); }
#pragma unroll
    for (int dd = 0; dd < 2; ++dd) { const unsigned char* Sg = (const unsigned char*)LT + ((size_t)((dd * 32 + b * 4 + head) * 128 + c)) * 16384;
#pragma unroll
        for (int i = 0; i < 2; ++i) P.rawS[dd][i] = __builtin_nontemporal_load((const v4u*)(Sg + (size_t)(tid + 512 * i) * 16)); }
}
__device__ __forceinline__ void hgrn_out_item(const bf16* proj, const bf16* LT, const float* gnorm, bf16* ymix, LAS unsigned char* lds, int it, int tid, const HoP& R, int it_next, HoP& NX) {
    const int b = it >> 9, head = (it >> 7) & 3, c = it & 127;
    const int cp = tid & 63, pg = __builtin_amdgcn_readfirstlane(tid >> 6), lane = tid & 63, fr = lane & 15, fq = lane >> 4;
    LAS unsigned char* QTB = lds;
    LAS unsigned char* KTB = lds + 64 * CH_STRIDE;
    LAS unsigned char* VT = lds + 256 * CH_STRIDE;
    LAS unsigned char* PP = VT + 128 * TR_STRIDE;
    LAS unsigned char* S8 = PP + 64 * TR_STRIDE;
    LAS float* TF = (LAS float*)(S8 + 2 * 128 * TR_STRIDE);
    LAS float* TB = TF + 1024;
    LAS float* RS = TB + 1024;
    const int ti = pg & 3, hv = pg >> 2;
    v2u gzr[4];
    { const size_t rowg = (size_t)b * SEQ + c * 64 + 16 * ti + fr;
#pragma unroll
      for (int t = 0; t < 4; ++t) gzr[t] = __builtin_nontemporal_load((const v2u*)(proj + rowg * INC + 2560 + head * 128 + 64 * hv + 16 * t + 4 * fq)); }
    { float tf0 = 0.f, tf1 = 0.f, tb0 = 0.f, tb1 = 0.f;
#pragma unroll
      for (int i = 0; i < 8; ++i) { tf0 += fast_ln(1.0f - bflo(R.rkf[i])); tf1 += fast_ln(1.0f - bfhi(R.rkf[i])); tb0 += fast_ln(1.0f - bflo(R.rkb[i])); tb1 += fast_ln(1.0f - bfhi(R.rkb[i])); }
      *(LAS f32x2*)(TF + pg * 128 + 2 * cp) = (f32x2){tf0, tf1}; *(LAS f32x2*)(TB + pg * 128 + 2 * cp) = (f32x2){tb0, tb1};
      v4u w0, w1;
      w0.x = (R.rv[0] & 0xffffu) | (R.rv[1] << 16); w0.y = (R.rv[2] & 0xffffu) | (R.rv[3] << 16); w0.z = (R.rv[4] & 0xffffu) | (R.rv[5] << 16); w0.w = (R.rv[6] & 0xffffu) | (R.rv[7] << 16);
      w1.x = (R.rv[0] >> 16) | (R.rv[1] & 0xffff0000u); w1.y = (R.rv[2] >> 16) | (R.rv[3] & 0xffff0000u); w1.z = (R.rv[4] >> 16) | (R.rv[5] & 0xffff0000u); w1.w = (R.rv[6] >> 16) | (R.rv[7] & 0xffff0000u);
      *(LAS v4u*)(VT + (2 * cp) * TR_STRIDE + pg * 16) = w0; *(LAS v4u*)(VT + (2 * cp + 1) * TR_STRIDE + pg * 16) = w1; }
    __syncthreads();
    if (it_next < 4096) hgrn_out_loadp(proj, LT, it_next, tid, NX);
#pragma unroll
    for (int dir = 0; dir < 2; ++dir) {
        const LAS float* TT = dir ? TB : TF; float o0 = 0.f, o1 = 0.f;
        LAS unsigned char* QT = QTB + dir * 128 * CH_STRIDE; LAS unsigned char* KT = KTB + dir * 128 * CH_STRIDE;
#pragma unroll
        for (int p = 0; p < 8; ++p) { const f32x2 a = *(const LAS f32x2*)(TT + p * 128 + 2 * cp); if (dir ? (p > pg) : (p < pg)) { o0 += a.x; o1 += a.y; } }
#pragma unroll
        for (int ii = 0; ii < 8; ++ii) { const int i = dir ? (7 - ii) : ii; const unsigned rk = dir ? R.rkb[i] : R.rkf[i];
            const float k0 = bflo(rk), k1 = bfhi(rk); o0 += fast_ln(1.0f - k0); o1 += fast_ln(1.0f - k1);
            const float e0 = __expf(o0), e1 = __expf(o1), n0 = __expf(-o0), n1 = __expf(-o1);
            *(LAS unsigned*)(QT + (8 * pg + i) * CH_STRIDE + 4 * cp) = pk2(bflo(R.rq[i]) * e0, bfhi(R.rq[i]) * e1);
            *(LAS unsigned*)(KT + (8 * pg + i) * CH_STRIDE + 4 * cp) = pk2(k0 * n0, k1 * n1); }
    }
#pragma unroll
    for (int dd = 0; dd < 2; ++dd)
#pragma unroll
        for (int i = 0; i < 2; ++i) { const int e = tid + 512 * i; *(LAS v4u*)(S8 + dd * 128 * TR_STRIDE + (e >> 3) * TR_STRIDE + (e & 7) * 16) = R.rawS[dd][i]; }
    __syncthreads();
    bf16x8 yq[2][4];
#pragma unroll
    for (int dir = 0; dir < 2; ++dir)
#pragma unroll
        for (int ks = 0; ks < 4; ++ks) yq[dir][ks] = *(const LAS bf16x8*)(QTB + dir * 128 * CH_STRIDE + (16 * ti + fr) * CH_STRIDE + (32 * ks + 8 * fq) * 2);
#pragma unroll
    for (int jj = 0; jj < 2; ++jj) { const int tj = 2 * hv + jj; f32x4 st = (f32x4){0.f, 0.f, 0.f, 0.f};
        const int ipos = 16 * ti + fr, j0 = 16 * tj + 4 * fq;
#pragma unroll
        for (int dir = 0; dir < 2; ++dir) {
            if (dir ? (tj >= ti) : (tj <= ti)) { f32x4 sd = (f32x4){0.f, 0.f, 0.f, 0.f};
#pragma unroll
                for (int ks = 0; ks < 4; ++ks) { const bf16x8 x = *(const LAS bf16x8*)(KTB + dir * 128 * CH_STRIDE + (16 * tj + fr) * CH_STRIDE + (32 * ks + 8 * fq) * 2); sd = mfma16(x, yq[dir][ks], sd); }
#pragma unroll
                for (int e = 0; e < 4; ++e) { const bool keep = dir ? (j0 + e >= ipos) : (j0 + e <= ipos); st[e] += keep ? sd[e] : 0.f; } } }
        *(LAS v2u*)(PP + (16 * ti + fr) * TR_STRIDE + (16 * tj + 4 * fq) * 2) = (v2u){pk2(st[0], st[1]), pk2(st[2], st[3])}; }
    __syncthreads();
    f32x4 acc[4], acci[4];
    { bf16x8 yp[2];
#pragma unroll
      for (int ks = 0; ks < 2; ++ks) yp[ks] = *(const LAS bf16x8*)(PP + (16 * ti + fr) * TR_STRIDE + (32 * ks + 8 * fq) * 2);
#pragma unroll
      for (int t = 0; t < 4; ++t) { const int tv = 4 * hv + t; acc[t] = (f32x4){0.f, 0.f, 0.f, 0.f}; acci[t] = acc[t];
#pragma unroll
          for (int ks = 0; ks < 2; ++ks) { const bf16x8 x = *(const LAS bf16x8*)(VT + (16 * tv + fr) * TR_STRIDE + (32 * ks + 8 * fq) * 2); acc[t] = mfma16(x, yp[ks], acc[t]); }
#pragma unroll
          for (int dir = 0; dir < 2; ++dir)
#pragma unroll
              for (int ks = 0; ks < 4; ++ks) { const bf16x8 x = frag_fp8(S8 + dir * 128 * TR_STRIDE + (16 * tv + fr) * TR_STRIDE + 32 * ks + 8 * fq); acci[t] = mfma16(x, yq[dir][ks], acci[t]); }
          acc[t] = acc[t] + acci[t] * ST_INV; } }
    float ss = 0.f;
#pragma unroll
    for (int t = 0; t < 4; ++t) ss += (acc[t][0] * acc[t][0] + acc[t][1] * acc[t][1]) + (acc[t][2] * acc[t][2] + acc[t][3] * acc[t][3]);
    ss += __shfl_xor(ss, 16); ss += __shfl_xor(ss, 32);
    if (fq == 0) RS[hv * 64 + 16 * ti + fr] = ss;
    __syncthreads();
    const float r = __builtin_amdgcn_rsqf((RS[16 * ti + fr] + RS[64 + 16 * ti + fr]) * (1.0f / 128.0f) + EPS);
    const size_t row = (size_t)b * SEQ + c * 64 + 16 * ti + fr;
#pragma unroll
    for (int t = 0; t < 4; ++t) { const int vcol = 64 * hv + 16 * t + 4 * fq; const f32x4 gn = *(const f32x4*)(gnorm + vcol);
        const v2u gz = gzr[t];
        *(v2u*)(ymix + row * D + 512 + head * 128 + vcol) = (v2u){pk2(acc[t][0] * r * gn[0] * bflo(gz.x), acc[t][1] * r * gn[1] * bfhi(gz.x)), pk2(acc[t][2] * r * gn[2] * bflo(gz.y), acc[t][3] * r * gn[3] * bfhi(gz.y))}; }
}

__device__ __forceinline__ void final_norm(const bf16* hb, float* out, const float* ssq3, const float* wf, int gw, int NGW, int lane) {
    f32x4 w4[4];
#pragma unroll
    for (int j = 0; j < 2; ++j) { w4[2 * j] = *(const f32x4*)(wf + 512 * j + lane * 8); w4[2 * j + 1] = *(const f32x4*)(wf + 512 * j + lane * 8 + 4); }
    for (int m = gw; m < M; m += NGW) {
        const float r = __builtin_amdgcn_rsqf(ssq3[m] * (1.0f / 1024.0f) + EPS);
        const v4u h0 = __builtin_nontemporal_load((const v4u*)(hb + (size_t)m * D + lane * 8)), h1 = __builtin_nontemporal_load((const v4u*)(hb + (size_t)m * D + 512 + lane * 8));
        float* o = out + (size_t)m * D + lane * 8;
        __builtin_nontemporal_store((f32x4){bflo(h0.x), bfhi(h0.x), bflo(h0.y), bfhi(h0.y)} * r * w4[0], (f32x4*)(o));
        __builtin_nontemporal_store((f32x4){bflo(h0.z), bfhi(h0.z), bflo(h0.w), bfhi(h0.w)} * r * w4[1], (f32x4*)(o + 4));
        __builtin_nontemporal_store((f32x4){bflo(h1.x), bfhi(h1.x), bflo(h1.y), bfhi(h1.y)} * r * w4[2], (f32x4*)(o + 512));
        __builtin_nontemporal_store((f32x4){bflo(h1.z), bfhi(h1.z), bflo(h1.w), bfhi(h1.w)} * r * w4[3], (f32x4*)(o + 516));
    }
}

__global__ void __launch_bounds__(NWAVES * 64, 2) mk_fwd(Args args) {
    extern __shared__ __attribute__((aligned(16))) unsigned char lds_raw[];
    cg::grid_group grid = cg::this_grid();
    LAS unsigned char* lds = (LAS unsigned char*)lds_raw;
    const int tid = threadIdx.x, lane = tid & 63, wave = __builtin_amdgcn_readfirstlane(tid >> 6);
    const int G = gridDim.x, bx = blockIdx.x;
    const int vcu = (G % 8 == 0) ? (bx % 8) * (G / 8) + bx / 8 : bx;
    const int gw = vcu * NWAVES + wave, NGW = G * NWAVES;
    unsigned char* ws = args.ws;
    float* ssq = (float*)(ws + WS_SSQ);
    bf16* actb = (bf16*)(ws + WS_ACTB); bf16* ymix = (bf16*)(ws + WS_YMIX); bf16* proj = (bf16*)(ws + WS_PROJ); bf16* hid = (bf16*)(ws + WS_PROJ);
    bf16* LT = (bf16*)(ws + WS_LT); float* DV = args.out; bf16* pooled = (bf16*)(ws + WS_POOLED);

    volatile LAS unsigned* MISC = (volatile LAS unsigned*)(lds + 143360);
    if (tid < 32) MISC[tid] = 0u;
    __syncthreads();
    const XcdBarrier bar = xcd_barrier_post((unsigned*)(ws + WS_BAR), MISC + 8);
    p0_prologue(args, lds, gw, NGW, wave, lane);
    if (args.ws == nullptr) grid.sync();
    xcd_barrier(bar);
    { pg8::Gemm g{actb, (const bf16*)(ws + WS_WGU1), M, 2 * FF, D}; pg8::StaticOrder S; S.init(M, 2 * FF, G, bx);
      pg8::EpiSwiglu E{hid, FF, ssq};
      pg8::gemm_phase<pg8::EpiSwiglu, pg8::StaticOrder, true, true>(lds, g, S, E); }
    xcd_barrier(bar);
    { pg8::Gemm g{hid, (const bf16*)(ws + WS_WD1), M, D, FF}; pg8::StaticOrder S; S.init(M, D, G, bx, 1);
      pg8::EpiResid E{actb, ssq + M, 0.5f, D};
      pg8::gemm_phase<pg8::EpiResid, pg8::StaticOrder, true, true>(lds, g, S, E); }
    xcd_barrier(bar);
    { pg8::Gemm g{actb, (const bf16*)(ws + WS_WIN), M, INC, D}; pg8::StaticOrder S; S.init(M, INC, G, bx);
      pg8::EpiProj E{proj, INC, ssq + M, (const float*)(ws + WS_OMLB)};
      pg8::gemm_phase<pg8::EpiProj, pg8::StaticOrder, true, true>(lds, g, S, E); }
    xcd_barrier(bar);
    pool_rows(proj, ymix, gw, NGW, lane);
    { HlP LA, LB; int it = bx;
      if (it < 4096) hgrn_local_loadp(proj, it, tid, LA);
      for (; it < 4096; it += 2 * G) {
          hgrn_local_item(proj, LT, DV, lds, it, tid, LA, (it + G < 4096) ? it + G : -1, LB);
          if (it + G < 4096) hgrn_local_item(proj, LT, DV, lds, it + G, tid, LB, (it + 2 * G < 4096) ? it + 2 * G : -1, LA); } }
    xcd_barrier(bar);
    hgrn_state_scan(LT, DV, bx * (NWAVES * 64) + tid, G * NWAVES * 64);
    xcd_barrier(bar);
    { HoP PA, PB; int it = bx;
      if (it < 4096) hgrn_out_loadp(proj, LT, it, tid, PA);
      for (; it < 4096; it += 2 * G) {
          hgrn_out_item(proj, LT, args.in[10], ymix, lds, it, tid, PA, it + G, PB);
          if (it + G < 4096) hgrn_out_item(proj, LT, args.in[10], ymix, lds, it + G, tid, PB, it + 2 * G, PA); } }
    xcd_barrier(bar);
    { pg8::Gemm g{ymix, (const bf16*)(ws + WS_WOUT), M, D, D}; pg8::StaticOrder S; S.init(M, D, G, bx);
      pg8::EpiResid E{actb, ssq + 2 * M, 1.0f, D};
      pg8::gemm_phase<pg8::EpiResid, pg8::StaticOrder, true, true>(lds, g, S, E); }
    xcd_barrier(bar);
    { pg8::Gemm g{actb, (const bf16*)(ws + WS_WGU2), M, 2 * FF, D}; pg8::StaticOrder S; S.init(M, 2 * FF, G, bx);
      pg8::EpiSwiglu E{hid, FF, ssq + 2 * M};
      pg8::gemm_phase<pg8::EpiSwiglu, pg8::StaticOrder, true, true>(lds, g, S, E); }
    xcd_barrier(bar);
    { pg8::Gemm g{hid, (const bf16*)(ws + WS_WD2), M, D, FF}; pg8::StaticOrder S; S.init(M, D, G, bx, 1);
      pg8::EpiResid E{actb, ssq + 3 * M, 0.5f, D};
      pg8::gemm_phase<pg8::EpiResid, pg8::StaticOrder, true, true>(lds, g, S, E); }
    xcd_barrier(bar);
    final_norm(actb, args.out, ssq + 3 * M, args.in[16], gw, NGW, lane);
}

extern "C" void kernel_launch(void* const* d_in, const int* in_sizes, int n_in, void* d_out, int out_size, void* d_ws, size_t ws_size, hipStream_t stream) {
    static int grid = 0;
    if (grid == 0) {
        if (n_in != 17 || in_sizes[0] != M * D || out_size != M * D || ws_size < WS_END) { fprintf(stderr, "kernel_launch: unexpected shapes: n_in %d in0 %d out %d ws %zu\n", n_in, n_in > 0 ? in_sizes[0] : -1, out_size, ws_size); grid = -1; return; }
        int dev = 0, cus = 0, per_cu = 0;
        if (hipGetDevice(&dev) != hipSuccess || hipDeviceGetAttribute(&cus, hipDeviceAttributeMultiprocessorCount, dev) != hipSuccess) { grid = -1; return; }
        if (hipFuncSetAttribute((const void*)mk_fwd, hipFuncAttributeMaxDynamicSharedMemorySize, LDS_BYTES) != hipSuccess) { fprintf(stderr, "kernel_launch: hipFuncSetAttribute failed\n"); grid = -1; return; }
        if (hipOccupancyMaxActiveBlocksPerMultiprocessor(&per_cu, (const void*)mk_fwd, NWAVES * 64, LDS_BYTES) != hipSuccess || per_cu < 1) { fprintf(stderr, "kernel_launch: occupancy query says %d\n", per_cu); per_cu = 1; }
        (void)hipGetLastError();
        grid = cus * 1;
    }
    if (grid < 0) return;
    if (hipMemsetAsync((char*)d_ws + WS_BAR, 0, 16384, stream) != hipSuccess) { fprintf(stderr, "kernel_launch: memset of barrier words failed\n"); return; }
    Args a{};
    for (int i = 0; i < 17; ++i) a.in[i] = (const float*)d_in[i];
    a.out = (float*)d_out; a.ws = (unsigned char*)d_ws;
    void* kargs[] = {&a};
    hipError_t e = hipLaunchCooperativeKernel((const void*)mk_fwd, dim3(grid), dim3(NWAVES * 64), kargs, LDS_BYTES, stream);
    if (e != hipSuccess) fprintf(stderr, "kernel_launch: cooperative launch failed: %s (grid %d)\n", hipGetErrorString(e), grid);
}
```
